# Optimizing an MI355X kernel written in HIP

```python
import math
import jax, jax.numpy as jnp
from jax import lax
import numpy as np

D_MODEL = 1024
BATCH = 16
SEQ = 2048
DEPTH = 2

CHUNK = 64
Q_BLOCK = 128
N_MIXERS = 2
N_A_LAYERS = (DEPTH + 1) // 2
N_B_LAYERS = DEPTH // 2
FOX_HEADS = 16
FOX_HEAD_DIM = D_MODEL // FOX_HEADS
GLA_HEADS = 4
GLA_DK = D_MODEL // 2
GLA_DV = D_MODEL
GLA_HK = GLA_DK // GLA_HEADS
GLA_HV = GLA_DV // GLA_HEADS
GLA_RANK = 16
GLA_TAU = 16.0
FFN_HIDDEN = int(math.ceil(8 * D_MODEL / 3 / 256) * 256)
N_MOD = 6
EPS = 1e-6

kernel_name = "fox_gla_adaln_hybrid_trunk"


def rms_norm(x, g):
    xf = x.astype(jnp.float32)
    y = xf * lax.rsqrt(jnp.mean(xf * xf, axis=-1, keepdims=True) + EPS)
    return (y * g.astype(jnp.float32)).astype(x.dtype)


def modulate(h, shift, scale):
    return h * (1.0 + scale[:, None, :]) + shift[:, None, :]


def forgetting_attention(h, w_in, b_f, w_out):
    B, S, _ = h.shape
    proj = h @ w_in
    q, k, v, f_logit = jnp.split(proj, [D_MODEL, 2 * D_MODEL, 3 * D_MODEL], axis=-1)
    q = q.reshape(B, S, FOX_HEADS, FOX_HEAD_DIM)
    k = k.reshape(B, S, FOX_HEADS, FOX_HEAD_DIM)
    v = v.reshape(B, S, FOX_HEADS, FOX_HEAD_DIM)
    log_f = jax.nn.log_sigmoid(f_logit.astype(jnp.float32) + b_f.astype(jnp.float32))
    cum = jnp.cumsum(log_f, axis=1).transpose(0, 2, 1)
    scale = FOX_HEAD_DIM ** -0.5
    outs = []
    for blk in range(S // Q_BLOCK):
        qs, qe = blk * Q_BLOCK, (blk + 1) * Q_BLOCK
        logits = jnp.einsum('bqhd,bkhd->bhqk', q[:, qs:qe], k[:, :qe]).astype(jnp.float32) * scale
        logits = logits + cum[:, :, qs:qe, None] - cum[:, :, None, :qe]
        mask = (qs + jnp.arange(Q_BLOCK))[:, None] >= jnp.arange(qe)[None, :]
        logits = jnp.where(mask[None, None], logits, -jnp.inf)
        p = jax.nn.softmax(logits, axis=-1).astype(v.dtype)
        outs.append(jnp.einsum('bhqk,bkhd->bqhd', p, v[:, :qe]))
    o = jnp.concatenate(outs, axis=1).reshape(B, S, D_MODEL)
    return o @ w_out


def gated_linear_attention(h, w_in, w_a2, b_a, g_o, w_out):
    B, S, _ = h.shape
    N = S // CHUNK
    proj = h @ w_in
    q, k, v, r, a_lr = jnp.split(
        proj, [GLA_DK, 2 * GLA_DK, 2 * GLA_DK + GLA_DV, 2 * GLA_DK + 2 * GLA_DV], axis=-1)
    log_alpha = jax.nn.log_sigmoid((a_lr @ w_a2 + b_a).astype(jnp.float32)) / GLA_TAU
    q = (q.astype(jnp.float32) * GLA_HK ** -0.5).reshape(B, N, CHUNK, GLA_HEADS, GLA_HK)
    k = k.astype(jnp.float32).reshape(B, N, CHUNK, GLA_HEADS, GLA_HK)
    v = v.astype(jnp.float32).reshape(B, N, CHUNK, GLA_HEADS, GLA_HV)
    b = jnp.cumsum(log_alpha.reshape(B, N, CHUNK, GLA_HEADS, GLA_HK), axis=2)
    b_last = b[:, :, -1]
    q_in = q * jnp.exp(b)
    k_in = k * jnp.exp(-b)
    A = jnp.einsum('bnthk,bnshk->bnhts', q_in, k_in)
    tril = jnp.tril(jnp.ones((CHUNK, CHUNK), dtype=bool))
    A = jnp.where(tril, A, 0.0)
    o_intra = jnp.einsum('bnhts,bnshv->bnthv', A, v)
    k_dec = k * jnp.exp(b_last[:, :, None] - b)
    kv = jnp.einsum('bnshk,bnshv->bnhkv', k_dec, v)

    def step(state, xs):
        dec, kv_n = xs
        return dec[..., None] * state + kv_n, state

    state0 = jnp.zeros((B, GLA_HEADS, GLA_HK, GLA_HV), jnp.float32)
    _, s_prev = lax.scan(step, state0, (jnp.moveaxis(jnp.exp(b_last), 1, 0), jnp.moveaxis(kv, 1, 0)))
    o_inter = jnp.einsum('bnthk,nbhkv->bnthv', q_in, s_prev)
    o = (o_intra + o_inter).reshape(B, S, GLA_HEADS, GLA_HV)
    o = o * lax.rsqrt(jnp.mean(o * o, axis=-1, keepdims=True) + EPS)
    o = o.reshape(B, S, GLA_DV) * g_o.astype(jnp.float32)
    o = (o * jax.nn.silu(r.astype(jnp.float32))).astype(h.dtype)
    return o @ w_out


def swiglu(h, w_in, w_out):
    gate, up = jnp.split(h @ w_in, 2, axis=-1)
    return (jax.nn.silu(gate) * up) @ w_out


def setup_inputs(seed: int = 0) -> dict:
    key = jax.random.key(seed)
    ks = jax.random.split(key, 20)
    f32 = jnp.float32

    def nrm(k, shape, fan_in, mult=1.0):
        return jax.random.normal(k, shape, f32) * (mult * fan_in ** -0.5)

    D = D_MODEL
    fox_cols = 3 * D + FOX_HEADS
    gla_cols = 2 * GLA_DK + 2 * GLA_DV + GLA_RANK
    return {
        "x": jax.random.normal(ks[0], (BATCH, SEQ, D), f32),
        "c": jax.random.normal(ks[1], (BATCH, D), f32),
        "ada_w": nrm(ks[2], (DEPTH, D, N_MOD * D), D, 0.5),
        "ada_b": 0.01 * jax.random.normal(ks[3], (DEPTH, N_MOD * D), f32),
        "norm1_g": 1.0 + 0.02 * jax.random.normal(ks[4], (DEPTH, D), f32),
        "norm2_g": 1.0 + 0.02 * jax.random.normal(ks[5], (DEPTH, D), f32),
        "ffn_w_in": nrm(ks[6], (DEPTH, D, 2 * FFN_HIDDEN), D),
        "ffn_w_out": nrm(ks[7], (DEPTH, FFN_HIDDEN, D), FFN_HIDDEN),
        "fox_w_in": nrm(ks[8], (N_A_LAYERS, D, fox_cols), D),
        "fox_b_f": jax.random.uniform(ks[9], (N_A_LAYERS, FOX_HEADS), f32, 1.0, 4.0),
        "fox_w_out": nrm(ks[10], (N_A_LAYERS, D, D), D),
        "gla_w_in": nrm(ks[11], (N_B_LAYERS, D, gla_cols), D),
        "gla_w_a2": nrm(ks[12], (N_B_LAYERS, GLA_RANK, GLA_DK), GLA_RANK),
        "gla_b_a": 0.1 * jax.random.normal(ks[13], (N_B_LAYERS, GLA_DK), f32),
        "gla_g_o": 1.0 + 0.02 * jax.random.normal(ks[14], (N_B_LAYERS, GLA_DV), f32),
        "gla_w_out": nrm(ks[15], (N_B_LAYERS, GLA_DV, D), GLA_DV),
        "final_g": 1.0 + 0.02 * jax.random.normal(ks[16], (D,), f32),
    }


def reference(x, c, ada_w, ada_b, norm1_g, norm2_g, ffn_w_in, ffn_w_out,
              fox_w_in, fox_b_f, fox_w_out,
              gla_w_in, gla_w_a2, gla_b_a, gla_g_o, gla_w_out, final_g):
    c_act = jax.nn.silu(c)
    for i in range(DEPTH):
        mod = c_act @ ada_w[i] + ada_b[i]
        sh1, sc1, g1, sh2, sc2, g2 = jnp.split(mod, N_MOD, axis=-1)
        h = modulate(rms_norm(x, norm1_g[i]), sh1, sc1)
        j = i // N_MIXERS
        if i % N_MIXERS == 0:
            y = forgetting_attention(h, fox_w_in[j], fox_b_f[j], fox_w_out[j])
        else:
            y = gated_linear_attention(h, gla_w_in[j], gla_w_a2[j], gla_b_a[j], gla_g_o[j], gla_w_out[j])
        x = x + g1[:, None, :] * y
        h = modulate(rms_norm(x, norm2_g[i]), sh2, sc2)
        x = x + g2[:, None, :] * swiglu(h, ffn_w_in[i], ffn_w_out[i])
    return rms_norm(x, final_g)
```

```cpp
#include <hip/hip_runtime.h>
#include <cstdio>
#include <cstdint>
namespace pg8 {
#define PG8_LAS __attribute__((address_space(3)))
typedef unsigned short bf16_t;
typedef short bf16x8 __attribute__((ext_vector_type(8)));
typedef float f32x4 __attribute__((ext_vector_type(4)));
typedef unsigned u32x4 __attribute__((ext_vector_type(4)));
constexpr int BM = 256, BK = 64, HALF = 128, HTB = HALF * BK * 2  , STAGE_BYTES = 8 * HTB, NXCD = 8, WGM = 8;

__host__ __device__ __forceinline__ int lds_byte(int r, int c) { const int st = (r >> 4) * 2 + (c >> 5), rr = r & 15, cc = c & 31, ob = rr * 64 + cc * 2; return st * 1024 + (ob ^ (((ob >> 9) & 1) << 5)); }
__host__ __device__ __forceinline__ void stage_rc(int b, int& R, int& C) { const int st = b / 1024, sb = b % 1024, swz = sb ^ (((sb >> 9) & 1) << 5); R = (st >> 1) * 16 + swz / 64; C = (st & 1) * 32 + (swz % 64) / 2; }
__host__ __device__ __forceinline__ int perm32(int rho) { const int n = rho >> 4, i = rho & 15; return 8 * (i >> 2) + 4 * n + (i & 3); }

struct Unit { int pm, pn; };
struct Gemm { const bf16_t* A; const bf16_t* Bt; int M, N, K; };

struct StaticOrder {
    int nM, nN, nwg, G, c;
    __host__ __device__ void init(int M, int N, int G_, int c_) { nM = M / BM; nN = N / BM; nwg = nM * nN; G = G_; c = c_; }
    __host__ __device__ bool next(int i, Unit& u) const {
        const long L = (long)i * G + c; if (L >= nwg) return false;
        int wgid = (int)L; { const int q = nwg / NXCD, r = nwg % NXCD, xcd = wgid % NXCD, off = wgid / NXCD; wgid = (xcd < r ? xcd * (q + 1) : r * (q + 1) + (xcd - r) * q) + off; }
        const int nig = WGM * nN, gid = wgid / nig, fm = gid * WGM, gsz = (nM - fm) < WGM ? (nM - fm) : WGM;
        u.pm = fm + ((wgid % nig) % gsz); u.pn = (wgid % nig) / gsz; return true;
    }
    __device__ __forceinline__ void a_ready(const Unit&) const {}
    __device__ __forceinline__ void done(const Unit&) const {}
};

__device__ __forceinline__ unsigned cvt_pk_bf16(float lo, float hi) { unsigned r; asm volatile("v_cvt_pk_bf16_f32 %0, %1, %2" : "=v"(r) : "v"(lo), "v"(hi)); return r; }
typedef float f32x2 __attribute__((ext_vector_type(2)));
__device__ __forceinline__ f32x2 gelu_pk(f32x2 v) {
    const f32x2 av = __builtin_elementwise_abs(v), d = av * 0.2316418882f + 1.0f;
    f32x2 t; t.x = __builtin_amdgcn_rcpf(d.x); t.y = __builtin_amdgcn_rcpf(d.y);
    f32x2 q = t * 0.5307027145f + (-0.7265760135f); q = q * t + 0.7107068705f; q = q * t + (-0.142248368f); q = q * t + 0.127414796f; q = q * t;
    const f32x2 s = (v * v) * (-0.72134752044f);
    f32x2 e; e.x = __builtin_amdgcn_exp2f(s.x); e.y = __builtin_amdgcn_exp2f(s.y);
    const f32x2 m = v * (q * e), r = v - m;
    f32x2 o; o.x = v.x < 0.f ? m.x : r.x; o.y = v.y < 0.f ? m.y : r.y; return o;
}

template <int ACT  > struct EpiBf16 {
    static constexpr bool PERM = true, AFTER_DRAIN = false; static_assert(ACT == 0 || ACT == 1, "EpiBf16: ACT is 0 (none) or 1 (gelu_pk)");
    bf16_t* O; int ldc; const float* bias; int split_cols; size_t split_stride; float scale0;
    __device__ __forceinline__ void operator()(const f32x4 (&acc)[2][2][4][2], const Unit& u, int wr, int wc, int fr, int fq) const {
        const int row0 = u.pm * BM + wr * 64 + fr; int colt = u.pn * BM; bf16_t* base = O;
        float sc = 1.f; if (split_cols) { const int t = colt / split_cols; base += (size_t)t * split_stride; colt -= t * split_cols; if (t == 0) sc = scale0; }
        const int col0 = colt + wc * 32 + 8 * fq, bcol0 = u.pn * BM + wc * 32 + 8 * fq;
        f32x4 bv[2][2];
#pragma unroll
        for (int bj = 0; bj < 2; ++bj)
#pragma unroll
            for (int n = 0; n < 2; ++n) bv[bj][n] = bias ? *(const f32x4*)(bias + bcol0 + bj * HALF + 4 * n) : (f32x4){0.f, 0.f, 0.f, 0.f};
#pragma unroll
        for (int ai = 0; ai < 2; ++ai)
#pragma unroll
            for (int m = 0; m < 4; ++m) { bf16_t* rowp = base + (size_t)(row0 + ai * HALF + m * 16) * ldc + col0;
#pragma unroll
                for (int bj = 0; bj < 2; ++bj) { f32x4 v0 = acc[ai][bj][m][0] + bv[bj][0], v1 = acc[ai][bj][m][1] + bv[bj][1];
                    if (ACT == 1) { f32x2 a = gelu_pk((f32x2){v0[0], v0[1]}), b = gelu_pk((f32x2){v0[2], v0[3]}), c = gelu_pk((f32x2){v1[0], v1[1]}), d = gelu_pk((f32x2){v1[2], v1[3]});
                        v0 = (f32x4){a.x, a.y, b.x, b.y}; v1 = (f32x4){c.x, c.y, d.x, d.y}; }
                    v0 = v0 * sc; v1 = v1 * sc; u32x4 w; w.x = cvt_pk_bf16(v0[0], v0[1]); w.y = cvt_pk_bf16(v0[2], v0[3]); w.z = cvt_pk_bf16(v1[0], v1[1]); w.w = cvt_pk_bf16(v1[2], v1[3]);
                    *(u32x4*)(rowp + bj * HALF) = w; } }
    }
};

template <class Epi, class Sched, bool ALIGN_EPI = false, bool SP2 = false>
__device__ __forceinline__ void gemm_phase(PG8_LAS unsigned char* lds, const Gemm g, const Sched& S, const Epi& E) {
    int tid_ = threadIdx.x; asm volatile("" : "+v"(tid_));
    const int tid = tid_, wid = __builtin_amdgcn_readfirstlane(tid >> 6), lane = tid & 63, wr = wid >> 2, wc = wid & 3, fr = lane & 15, fq = lane >> 4;
    const int K = g.K, nt = K / BK;
    unsigned voffA[2], voffB[2];
#pragma unroll
    for (int i = 0; i < 2; ++i) { int R, C; stage_rc(tid * 16 + i * 8192, R, C); const int Rb = Epi::PERM ? ((R & ~31) + perm32(R & 31)) : R;
        voffA[i] = (unsigned)(R * K + C) * 2u; voffB[i] = (unsigned)(Rb * K + C) * 2u; }
    const size_t kstep = (size_t)(BK * 2);
    const size_t hstep = (size_t)HALF * K * 2;
    const size_t tstep = 2 * hstep;
    const unsigned ldsw = (unsigned)wid * 1024u;
    const int aoff = lds_byte(wr * 64 + fr, fq * 8), boff = lds_byte(wc * 32 + fr, fq * 8);
#define PG8_SA(b, h) (((b) * 2 + (h)) * HTB)
#define PG8_SB(b, h) ((4 + (b) * 2 + (h)) * HTB)
#define PG8_STAGE(bufoff, gbase, voff) do { _Pragma("unroll") for (int _i = 0; _i < 2; ++_i) \
        __builtin_amdgcn_global_load_lds((const unsigned*)((const char*)(gbase) + (voff)[_i]), (PG8_LAS unsigned*)(lds + (bufoff) + ldsw + _i * 8192), 16, 0, 0); } while (0)
#define PG8_LDA(dst, b, h) do { _Pragma("unroll") for (int m = 0; m < 4; ++m) _Pragma("unroll") for (int k = 0; k < 2; ++k) dst[m][k] = *(const PG8_LAS bf16x8*)(lds + PG8_SA(b, h) + aoff + m * 2048 + k * 1024); } while (0)
#define PG8_LDB(dst, b, h) do { _Pragma("unroll") for (int n = 0; n < 2; ++n) _Pragma("unroll") for (int k = 0; k < 2; ++k) dst[n][k] = *(const PG8_LAS bf16x8*)(lds + PG8_SB(b, h) + boff + n * 2048 + k * 1024); } while (0)
#define PG8_MMA(ai, bj, At, Bt) do { __builtin_amdgcn_s_setprio(1); _Pragma("unroll") for (int m = 0; m < 4; ++m) _Pragma("unroll") for (int n = 0; n < 2; ++n) _Pragma("unroll") for (int k = 0; k < 2; ++k) \
        acc[ai][bj][m][n] = __builtin_amdgcn_mfma_f32_16x16x32_bf16(Bt[n][k], At[m][k], acc[ai][bj][m][n], 0, 0, 0); __builtin_amdgcn_s_setprio(0); } while (0)
#define PG8_WAIT_V(n) asm volatile("s_waitcnt vmcnt(" #n ")" ::: "memory")
#define PG8_WAIT_L(n) asm volatile("s_waitcnt lgkmcnt(" #n ")" ::: "memory")
#define PG8_BAR __builtin_amdgcn_s_barrier()
#define PG8_SCHED __builtin_amdgcn_sched_barrier(0)
    Unit cur, nxt; int ui = 0;
    if (!S.next(0, cur)) return;
    f32x4 acc[2][2][4][2];
#pragma unroll
    for (int a = 0; a < 2; ++a)
#pragma unroll
        for (int b = 0; b < 2; ++b)
#pragma unroll
            for (int m = 0; m < 4; ++m)
#pragma unroll
                for (int n = 0; n < 2; ++n) acc[a][b][m][n] = (f32x4){0.f, 0.f, 0.f, 0.f};
    bf16x8 At[4][2], B0[2][2], B1[2][2];
    const char* cA = (const char*)g.A + (size_t)cur.pm * tstep; const char* cB = (const char*)g.Bt + (size_t)cur.pn * tstep;
    S.a_ready(cur);
    if constexpr (SP2) {
        PG8_STAGE(PG8_SB(0, 0), cB, voffB); PG8_STAGE(PG8_SB(0, 1), cB + hstep, voffB); PG8_STAGE(PG8_SA(0, 0), cA, voffA); PG8_STAGE(PG8_SA(0, 1), cA + hstep, voffA);
        if (wr == 1) PG8_BAR;
        PG8_WAIT_V(2); PG8_BAR;
        PG8_STAGE(PG8_SB(1, 0), cB + kstep, voffB); PG8_STAGE(PG8_SA(1, 0), cA + kstep, voffA); PG8_STAGE(PG8_SB(1, 1), cB + hstep + kstep, voffB);
        PG8_WAIT_V(6); PG8_BAR;
    } else {
        PG8_STAGE(PG8_SB(0, 0), cB, voffB); PG8_STAGE(PG8_SA(0, 0), cA, voffA); PG8_STAGE(PG8_SB(0, 1), cB + hstep, voffB); PG8_STAGE(PG8_SA(0, 1), cA + hstep, voffA);
        if (wr == 1) PG8_BAR;
        PG8_WAIT_V(4); PG8_BAR;
        PG8_STAGE(PG8_SB(1, 0), cB + kstep, voffB); PG8_STAGE(PG8_SA(1, 0), cA + kstep, voffA); PG8_STAGE(PG8_SB(1, 1), cB + hstep + kstep, voffB);
        PG8_WAIT_V(6); PG8_BAR;
    }
    for (;;) {
        const bool has_next = S.next(ui + 1, nxt);
        const char* nA = has_next ? (const char*)g.A + (size_t)nxt.pm * tstep : cA; const char* nB = has_next ? (const char*)g.Bt + (size_t)nxt.pn * tstep : cB;
        for (int t = 0; t < nt; t += 2) {
            const bool last = (t == nt - 2);
            const char* a1 = cA + (size_t)(t + 1) * kstep;
            const char* a2 = last ? nA : cA + (size_t)(t + 2) * kstep; const char* b2 = last ? nB : cB + (size_t)(t + 2) * kstep;
            const char* a3 = a2 + kstep; const char* b3 = b2 + kstep;
            if (last && has_next) S.a_ready(nxt);
            if constexpr (SP2) {
            PG8_LDB(B0, 0, 0); PG8_LDB(B1, 0, 1); PG8_SCHED; PG8_LDA(At, 0, 0); PG8_STAGE(PG8_SA(1, 1), a1 + hstep, voffA);
            PG8_WAIT_V(8); PG8_WAIT_L(0); PG8_BAR; PG8_MMA(0, 0, At, B0); PG8_MMA(0, 1, At, B1); PG8_BAR; PG8_SCHED;
            PG8_LDA(At, 0, 1); PG8_STAGE(PG8_SB(0, 0), b2, voffB); PG8_STAGE(PG8_SB(0, 1), b2 + hstep, voffB); PG8_STAGE(PG8_SA(0, 0), a2, voffA);
            PG8_WAIT_V(8); PG8_WAIT_L(0); PG8_BAR; PG8_MMA(1, 0, At, B0); PG8_MMA(1, 1, At, B1); PG8_BAR; PG8_SCHED;
            PG8_LDB(B0, 1, 0); PG8_LDB(B1, 1, 1); PG8_SCHED; PG8_LDA(At, 1, 0); PG8_STAGE(PG8_SA(0, 1), a2 + hstep, voffA);
            PG8_WAIT_V(8); PG8_WAIT_L(0); PG8_BAR; PG8_MMA(0, 0, At, B0); PG8_MMA(0, 1, At, B1); PG8_BAR; PG8_SCHED;
            PG8_LDA(At, 1, 1); PG8_STAGE(PG8_SB(1, 0), b3, voffB); PG8_STAGE(PG8_SB(1, 1), b3 + hstep, voffB); PG8_STAGE(PG8_SA(1, 0), a3, voffA);
            PG8_WAIT_V(8); PG8_WAIT_L(0); PG8_BAR; PG8_MMA(1, 0, At, B0); PG8_MMA(1, 1, At, B1); PG8_BAR; PG8_SCHED;
            } else {
            PG8_LDB(B0, 0, 0); PG8_SCHED; PG8_LDA(At, 0, 0); PG8_STAGE(PG8_SA(1, 1), a1 + hstep, voffA);
            PG8_WAIT_L(8); PG8_BAR; PG8_WAIT_L(0); PG8_MMA(0, 0, At, B0); PG8_BAR; PG8_SCHED;
            PG8_LDB(B1, 0, 1); PG8_STAGE(PG8_SB(0, 0), b2, voffB);
            PG8_BAR; PG8_WAIT_L(0); PG8_MMA(0, 1, At, B1); PG8_BAR;
            PG8_LDA(At, 0, 1); PG8_STAGE(PG8_SA(0, 0), a2, voffA);
            PG8_BAR; PG8_WAIT_L(0); PG8_MMA(1, 0, At, B0); PG8_BAR; PG8_SCHED;
            PG8_STAGE(PG8_SB(0, 1), b2 + hstep, voffB);
            PG8_WAIT_V(6); PG8_BAR; PG8_MMA(1, 1, At, B1); PG8_BAR;
            PG8_LDB(B0, 1, 0); PG8_SCHED; PG8_LDA(At, 1, 0); PG8_STAGE(PG8_SA(0, 1), a2 + hstep, voffA);
            PG8_WAIT_L(8); PG8_BAR; PG8_WAIT_L(0); PG8_MMA(0, 0, At, B0); PG8_BAR; PG8_SCHED;
            PG8_LDB(B1, 1, 1); PG8_STAGE(PG8_SB(1, 0), b3, voffB);
            PG8_BAR; PG8_WAIT_L(0); PG8_MMA(0, 1, At, B1); PG8_BAR;
            PG8_LDA(At, 1, 1); PG8_STAGE(PG8_SA(1, 0), a3, voffA);
            PG8_BAR; PG8_WAIT_L(0); PG8_MMA(1, 0, At, B0); PG8_BAR; PG8_SCHED;
            PG8_STAGE(PG8_SB(1, 1), b3 + hstep, voffB);
            PG8_WAIT_V(6); PG8_BAR; PG8_MMA(1, 1, At, B1); PG8_BAR;
            }
        }
        if constexpr (ALIGN_EPI) { if (wr == 0) PG8_BAR; }
        if constexpr (!Epi::AFTER_DRAIN) { E(acc, cur, wr, wc, fr, fq); S.done(cur); }
        if (!has_next) break;
#pragma unroll
        for (int a = 0; a < 2; ++a)
#pragma unroll
            for (int b = 0; b < 2; ++b)
#pragma unroll
                for (int m = 0; m < 4; ++m)
#pragma unroll
                    for (int n = 0; n < 2; ++n) acc[a][b][m][n] = (f32x4){0.f, 0.f, 0.f, 0.f};
        cur = nxt; cA = nA; cB = nB; ++ui;
        if constexpr (ALIGN_EPI) { if (wr == 1) PG8_BAR; }
    }
    PG8_WAIT_V(0);
    if constexpr (!ALIGN_EPI) { if (wr == 0) PG8_BAR; }
    PG8_BAR;
    if constexpr (Epi::AFTER_DRAIN) { E.fused(acc, cur, wr, wc, fr, fq, lds, wid, lane); S.done(cur); }
#undef PG8_SA
#undef PG8_SB
#undef PG8_STAGE
#undef PG8_LDA
#undef PG8_LDB
#undef PG8_MMA
#undef PG8_WAIT_V
#undef PG8_WAIT_L
#undef PG8_BAR
#undef PG8_SCHED
}
}

#ifndef PG8_SP2
#define PG8_SP2 true
#endif
#ifndef PG8_ALIGN
#define PG8_ALIGN true
#endif
#include <hip/hip_bf16.h>
#include <cmath>
namespace attn_body {
using bf16=__hip_bfloat16;
using bf16x8=__attribute__((ext_vector_type(8)))short;
using s16x4=__attribute__((ext_vector_type(4)))short;
using f32x16=__attribute__((ext_vector_type(16)))float;
using u32x4=__attribute__((ext_vector_type(4)))unsigned;
constexpr int BATCH=16,NHEAD=16,SEQ=2048,D=64,DM=NHEAD*D;
constexpr int NW=8,QBLK=32,QB=QBLK*NW,KVBLK=64,NQB=SEQ/QB;
constexpr int ATTN_PITCH=DM, ATTN_UNIT_ROWS=QB;
__device__ __forceinline__ int crow(int r,int hi){return (r&3)+8*(r>>2)+4*hi;}
#define SBAR() __builtin_amdgcn_sched_barrier(0)
__device__ __forceinline__ void cmask(f32x16&p0,f32x16&p1,int jb,int qrel,int hi){
  const float NEG=-INFINITY; int kb=64*jb+4*hi;
  #pragma unroll
  for(int r=0;r<16;++r){int kv=kb+(r&3)+8*(r>>2); if(kv>qrel)p0[r]=NEG; if(kv+32>qrel)p1[r]=NEG;}
}

constexpr int NSLOT=3, SLOTB=8192;
constexpr int LDS_K=0, LDS_V=NSLOT*SLOTB, LDS_WS=2*NSLOT*SLOTB, LDS_OST=LDS_WS+NW*64*4, LDS_BYTES=LDS_OST+NW*4096;
constexpr float C2=0.125f*1.4426950408889634f;
__device__ __forceinline__ void glds16(const void*gsrc,unsigned lds_dst){unsigned keep;
  asm volatile("s_mov_b32 %0, m0\n\ts_mov_b32 m0, %2\n\ts_nop 0\n\tglobal_load_lds_dwordx4 %1, off\n\ts_mov_b32 m0, %0":"=&s"(keep):"v"(gsrc),"s"(lds_dst):"memory");}
__device__ __forceinline__ float max3f(float a,float b,float c){float r;asm("v_max3_f32 %0, %1, %2, %3":"=v"(r):"v"(a),"v"(b),"v"(c));return r;}
__device__ __forceinline__ float max2f(float a,float b){float r;asm("v_max_f32_e32 %0, %1, %2":"=v"(r):"v"(a),"v"(b));return r;}
__device__ __forceinline__ float fadd_s(float a,float b){float r;asm("v_add_f32_e32 %0, %1, %2":"=v"(r):"v"(a),"v"(b));return r;}
__device__ __forceinline__ float fsub_s(float a,float b){float r;asm("v_sub_f32_e32 %0, %1, %2":"=v"(r):"v"(a),"v"(b));return r;}
typedef float f32x2_t __attribute__((ext_vector_type(2))); typedef __bf16 bf16x2_t __attribute__((ext_vector_type(2)));
__device__ __forceinline__ unsigned cvtpk_s(float lo,float hi){f32x2_t v={lo,hi};bf16x2_t b=__builtin_convertvector(v,bf16x2_t);return __builtin_bit_cast(unsigned,b);}
#define WAIT_BAR(N) asm volatile("s_waitcnt vmcnt(" #N ") lgkmcnt(0)\n\ts_barrier":::"memory")

__device__ __forceinline__ void qkt(f32x16&p0,f32x16&p1,const char*Kslot,const bf16x8*qr,const f32x16&c0,const f32x16&c1,int r32,int hi){
  const char*kb=Kslot+hi*1024+r32*16;
  #pragma unroll
  for(int d0=0;d0<4;++d0){
    const bf16x8 b0=*reinterpret_cast<const bf16x8*>(kb+d0*2048);
    const bf16x8 b1=*reinterpret_cast<const bf16x8*>(kb+d0*2048+512);
    if(d0==0){p0=__builtin_amdgcn_mfma_f32_32x32x16_bf16(b0,qr[0],c0,0,0,0);p1=__builtin_amdgcn_mfma_f32_32x32x16_bf16(b1,qr[0],c1,0,0,0);}
    else{p0=__builtin_amdgcn_mfma_f32_32x32x16_bf16(b0,qr[d0],p0,0,0,0);p1=__builtin_amdgcn_mfma_f32_32x32x16_bf16(b1,qr[d0],p1,0,0,0);}}
}
typedef __attribute__((address_space(3))) const char* lds_cptr;
typedef short v4i16_t __attribute__((ext_vector_type(4)));
__device__ __forceinline__ void kload8(bf16x8*kf,lds_cptr kp){
  kf[0]=*(const __attribute__((address_space(3))) bf16x8*)(kp);      kf[1]=*(const __attribute__((address_space(3))) bf16x8*)(kp+512);
  kf[2]=*(const __attribute__((address_space(3))) bf16x8*)(kp+2048); kf[3]=*(const __attribute__((address_space(3))) bf16x8*)(kp+2560);
  kf[4]=*(const __attribute__((address_space(3))) bf16x8*)(kp+4096); kf[5]=*(const __attribute__((address_space(3))) bf16x8*)(kp+4608);
  kf[6]=*(const __attribute__((address_space(3))) bf16x8*)(kp+6144); kf[7]=*(const __attribute__((address_space(3))) bf16x8*)(kp+6656);
}
__device__ __forceinline__ void kload2(bf16x8*kf,lds_cptr kp,int j){ kf[2*j]=*(const __attribute__((address_space(3))) bf16x8*)(kp+j*2048); kf[2*j+1]=*(const __attribute__((address_space(3))) bf16x8*)(kp+j*2048+512); }
__device__ __forceinline__ s16x4 vtr(lds_cptr p){ return __builtin_bit_cast(s16x4,__builtin_amdgcn_ds_read_tr16_b64_v4i16((__attribute__((address_space(3))) v4i16_t*)p)); }
__device__ __forceinline__ float rowmax(const f32x16&p0,const f32x16&p1){
  float a=max3f(p0[0],p0[1],p1[0]),b=max3f(p0[2],p0[3],p1[1]);a=max3f(a,p1[2],p1[3]);
  #pragma unroll
  for(int r=4;r<16;r+=4){a=max3f(a,p0[r],p0[r+1]);b=max3f(b,p0[r+2],p0[r+3]);a=max3f(a,p1[r],p1[r+1]);b=max3f(b,p1[r+2],p1[r+3]);}
  const float m=max2f(a,b);
  auto rr=__builtin_amdgcn_permlane32_swap(__float_as_uint(m),__float_as_uint(m),false,false);
  return max2f(__uint_as_float(rr[0]),__uint_as_float(rr[1]));
}
__device__ __forceinline__ void pv(f32x16*o,int vb,bf16x8 pa0,bf16x8 pa1,bf16x8 pa2,bf16x8 pa3){
  #pragma unroll
  for(int d0=0;d0<2;++d0){s16x4 lo[4],hi[4];
    #pragma unroll
    for(int ks=0;ks<4;++ks){
      asm volatile("ds_read_b64_tr_b16 %0,%1 offset:%c2":"=&v"(lo[ks]):"v"(vb),"i"(d0*4096+ks*1024):"memory");
      asm volatile("ds_read_b64_tr_b16 %0,%1 offset:%c2":"=&v"(hi[ks]):"v"(vb),"i"(d0*4096+ks*1024+512):"memory");}
    asm volatile("s_waitcnt lgkmcnt(0)":::"memory");SBAR();
    #define PK(k) (bf16x8){lo[k][0],lo[k][1],lo[k][2],lo[k][3],hi[k][0],hi[k][1],hi[k][2],hi[k][3]}
    o[d0]=__builtin_amdgcn_mfma_f32_32x32x16_bf16(pa0,PK(0),o[d0],0,0,0);
    o[d0]=__builtin_amdgcn_mfma_f32_32x32x16_bf16(pa1,PK(1),o[d0],0,0,0);
    o[d0]=__builtin_amdgcn_mfma_f32_32x32x16_bf16(pa2,PK(2),o[d0],0,0,0);
    o[d0]=__builtin_amdgcn_mfma_f32_32x32x16_bf16(pa3,PK(3),o[d0],0,0,0);
    #undef PK
  }
}

#ifndef ATTN_STORE16
#define ATTN_STORE16(p,v) (*(u32x4*)(p)=(v))
#endif
template<int THRL> __device__ __forceinline__ void attn_unit(int b,int h,int qb,const bf16*Q,const bf16*__restrict__ K,const bf16*__restrict__ V,bf16*O,char*shm,const __attribute__((address_space(3))) float*kbl){
  int tid_=threadIdx.x; asm volatile("":"+v"(tid_)); const int tid=tid_,lane=tid&63,r32=lane&31,hi=lane>>5; const int wid=__builtin_amdgcn_readfirstlane(tid>>6);
  const long rowbase=(long)b*SEQ; const int q0=qb*QB;
  const bf16*Qw=Q+(rowbase+q0+wid*QBLK)*DM+h*D;
  const bf16*Kh=K+rowbase*DM+h*D,*Vh=V+rowbase*DM+h*D;
  const unsigned lds0=(unsigned)(uintptr_t)shm;
  float*wsf=(float*)(shm+LDS_WS)+wid*64;
  const bf16*ksrc=Kh+(long)lane*DM+wid*8;
  const bf16*vsrc=Vh+(long)(16*(wid&3)+(lane>>2))*DM+(wid>>2)*32+(lane&3)*8;
  const unsigned kdst=lds0+LDS_K+wid*1024, vdst=lds0+LDS_V+wid*1024;
  #define DMA_K(t,slot) glds16(ksrc+(long)(t)*KVBLK*DM,(unsigned)__builtin_amdgcn_readfirstlane(kdst+(slot)))
  #define DMA_V(t,slot) glds16(vsrc+(long)(t)*KVBLK*DM,(unsigned)__builtin_amdgcn_readfirstlane(vdst+(slot)))
  const int vb0=(int)(lds0+LDS_V)+((lane>>4)&1)*32+(lane&3)*8+(4*hi+((lane&15)>>2))*64;
  const char*Kbase=shm+LDS_K; bf16x8 kf[8];
  const lds_cptr shm3=(lds_cptr)shm; const lds_cptr kp0=shm3+LDS_K+hi*1024+r32*16; const lds_cptr vp0=shm3+LDS_V+((lane>>4)&1)*32+(lane&3)*8+(4*hi+((lane&15)>>2))*64;
  const int NT=(q0+QB)/KVBLK;
  DMA_K(0,0);DMA_V(0,0);DMA_K(1,SLOTB);
  bf16x8 qr[4];
  #pragma unroll
  for(int d0=0;d0<4;++d0)qr[d0]=*reinterpret_cast<const bf16x8*>(&Qw[(long)r32*DM+d0*16+hi*8]);
  float mhat=0.f,l_reg=0.f;f32x16 o[2];o[0]=f32x16{};o[1]=f32x16{};float nm=0.f;
  const int qrel=wid*QBLK+r32;
  typedef float kb4_t __attribute__((ext_vector_type(4)));
  #define KB1(C,t,o) do{ const __attribute__((address_space(3))) float*kp_=kbl+64*(t)+4*hi+(o); \
    _Pragma("unroll") for(int j_=0;j_<4;++j_){ const kb4_t a_=*(const __attribute__((address_space(3))) kb4_t*)(kp_+8*j_); \
      _Pragma("unroll") for(int i_=0;i_<4;++i_){ C[4*j_+i_]=a_[i_]+nm; } } }while(0)
  #define CMASK(P0,P1,t) do{int jb_=(t)-(NT-4); if(jb_>=0)cmask(P0,P1,jb_,qrel,hi);}while(0)
  bool resc=false;
  #define START(P0,P1) do{ const float rm=rowmax(P0,P1); resc=false; \
    { const float dl=rm; mhat=fadd_s(mhat,dl); \
      _Pragma("unroll") for(int r=0;r<16;++r){P0[r]=fsub_s(P0[r],dl);P1[r]=fsub_s(P1[r],dl);} \
      nm=-mhat; } \
    _Pragma("unroll") for(int r=0;r<16;++r)P0[r]=__builtin_amdgcn_exp2f(P0[r]); }while(0)
  #define RESC() do{ if(resc){ asm volatile("s_waitcnt lgkmcnt(0)":::"memory"); \
      _Pragma("unroll") for(int d_=0;d_<2;++d_) _Pragma("unroll") for(int r=0;r<16;++r)o[d_][r]*=wsf[crow(r,hi)]; } }while(0)
  f32x16 pA0,pA1,pB0,pB1;
  int sl_prev=0,sl_cur=0,sl_next=SLOTB;
  #define ROT() do{sl_prev=sl_cur;sl_cur=sl_next;sl_next=(sl_next==(NSLOT-1)*SLOTB)?0:sl_next+SLOTB;}while(0)
  DMA_K(2,2*SLOTB);
  WAIT_BAR(3);
  { f32x16 cz0,cz1; KB1(cz0,0,0); KB1(cz1,0,32); qkt(pA0,pA1,Kbase,qr,cz0,cz1,r32,hi); } asm volatile("s_nop 15\n\ts_nop 7":"+v"(pA0),"+v"(pA1));CMASK(pA0,pA1,0);
  START(pA0,pA1);
  _Pragma("unroll") for(int r=0;r<16;++r)pA1[r]=__builtin_amdgcn_exp2f(pA1[r]);
  WAIT_BAR(0);
  DMA_K(3,0);DMA_V(1,SLOTB);
  ROT();
  kload8(kf,kp0+sl_cur);
  WAIT_BAR(2);
  s16x4 vlo[8],vhi[8]; u32x4 pw0,pw1,pw2,pw3;
  #define PKW(P,B) cvtpk_s(P[B],P[B+1])
  #define PAF(k) __builtin_bit_cast(bf16x8,pw##k)
  #define VFR(i) (bf16x8){vlo[i][0],vlo[i][1],vlo[i][2],vlo[i][3],vhi[i][0],vhi[i][1],vhi[i][2],vhi[i][3]}
  #define PIN(x) asm volatile("":"+v"(x))
  #define MX3(a,b,c) __builtin_fmaxf(__builtin_fmaxf((a),(b)),(c))
  #define GAPA(MF,A0,A1,A2,A3,W0,W1,PW) do{ MF; sacc+=A0; sacc+=A1; sacc+=A2; sacc+=A3; PIN(sacc); W0; W1; PIN(PW); SBAR(); }while(0)
  #define EX(v) __builtin_amdgcn_exp2f(v)
  #define GAPB(MF,X,B) do{ MF; X[B]=EX(X[B]); X[B+1]=EX(X[B+1]); X[B+2]=EX(X[B+2]); X[B+3]=EX(X[B+3]); PIN(X); SBAR(); }while(0)
  #define VRD(i) do{ vlo[i]=vtr(vp_+(((i)>>2)*4096+((i)&3)*1024)); vhi[i]=vtr(vp_+(((i)>>2)*4096+((i)&3)*1024+512)); }while(0)
  #define KRD(G,j) do{ if(G){ kload2(kf,kp0+sl_next,j); SBAR(); } }while(0)
  #define STEP(C0,C1,P0,P1,t,GK,GV,GL) do{ SBAR(); \
    const lds_cptr vp_=vp0+sl_prev; KB1(C0,t,0); SBAR(); \
    VRD(0); SBAR(); float sacc=(P0[0]+P0[1]); \
    GAPA(C0=__builtin_amdgcn_mfma_f32_32x32x16_bf16(kf[0],qr[0],C0,0,0,0), P0[2],P0[3],P0[4],P0[5],     pw0[0]=PKW(P0,0), pw0[1]=PKW(P0,2), pw0); \
    KB1(C1,t,32); VRD(4); SBAR(); GAPA(C1=__builtin_amdgcn_mfma_f32_32x32x16_bf16(kf[1],qr[0],C1,0,0,0), P0[6],P0[7],P0[8],P0[9],     pw0[2]=PKW(P0,4), pw0[3]=PKW(P0,6), pw0); \
    VRD(1); SBAR(); GAPA(C0=__builtin_amdgcn_mfma_f32_32x32x16_bf16(kf[2],qr[1],C0,0,0,0),   P0[10],P0[11],P0[12],P0[13], pw1[0]=PKW(P0,8), pw1[1]=PKW(P0,10), pw1); \
    VRD(5); SBAR(); GAPA(C1=__builtin_amdgcn_mfma_f32_32x32x16_bf16(kf[3],qr[1],C1,0,0,0),   P0[14],P0[15],P1[0],P1[1],   pw1[2]=PKW(P0,12),pw1[3]=PKW(P0,14), pw1); \
    VRD(2); SBAR(); GAPA(C0=__builtin_amdgcn_mfma_f32_32x32x16_bf16(kf[4],qr[2],C0,0,0,0),   P1[2],P1[3],P1[4],P1[5],     pw2[0]=PKW(P1,0), pw2[1]=PKW(P1,2), pw2); \
    VRD(6); SBAR(); GAPA(C1=__builtin_amdgcn_mfma_f32_32x32x16_bf16(kf[5],qr[2],C1,0,0,0),   P1[6],P1[7],P1[8],P1[9],     pw2[2]=PKW(P1,4), pw2[3]=PKW(P1,6), pw2); \
    VRD(3); SBAR(); GAPA(C0=__builtin_amdgcn_mfma_f32_32x32x16_bf16(kf[6],qr[3],C0,0,0,0),   P1[10],P1[11],P1[12],P1[13], pw3[0]=PKW(P1,8), pw3[1]=PKW(P1,10), pw3); \
    VRD(7); SBAR(); GAPA(C1=__builtin_amdgcn_mfma_f32_32x32x16_bf16(kf[7],qr[3],C1,0,0,0),   P1[14],P1[15],0.f,0.f,       pw3[2]=PKW(P1,12),pw3[3]=PKW(P1,14), pw3); \
    l_reg+=sacc; \
    if(GK){DMA_K((t)+3,sl_cur);} if(GV){DMA_V((t)+1,sl_next);} \
    CMASK(C0,C1,t); \
    { float a=MX3(C0[0],C0[1],C1[0]),b=MX3(C0[2],C0[3],C1[1]); a=MX3(a,C1[2],C1[3]); \
      _Pragma("unroll") for(int r=4;r<16;r+=4){a=MX3(a,C0[r],C0[r+1]);b=MX3(b,C0[r+2],C0[r+3]);a=MX3(a,C1[r],C1[r+1]);b=MX3(b,C1[r+2],C1[r+3]);} \
      float rm=__builtin_fmaxf(a,b); { auto rr=__builtin_amdgcn_permlane32_swap(__float_as_uint(rm),__float_as_uint(rm),false,false); rm=__builtin_fmaxf(__uint_as_float(rr[0]),__uint_as_float(rr[1])); } \
      resc=false; \
      if(__builtin_expect(__any(rm>(float)THRL),0)){ const float dl=__builtin_fmaxf(rm,0.f); mhat+=dl; \
        _Pragma("unroll") for(int r=0;r<16;++r){C0[r]-=dl;C1[r]-=dl;} \
        nm=-mhat; \
        const float f=__builtin_amdgcn_exp2f(-dl); l_reg*=f; if(hi==0)wsf[r32]=f; resc=true; } } \
    SBAR(); \
    GAPB(o[0]=__builtin_amdgcn_mfma_f32_32x32x16_bf16(PAF(0),VFR(0),o[0],0,0,0), C0,0); \
    GAPB(o[1]=__builtin_amdgcn_mfma_f32_32x32x16_bf16(PAF(0),VFR(4),o[1],0,0,0), C0,4); \
    KRD(GL,0); GAPB(o[0]=__builtin_amdgcn_mfma_f32_32x32x16_bf16(PAF(1),VFR(1),o[0],0,0,0), C0,8); \
    KRD(GL,1); GAPB(o[1]=__builtin_amdgcn_mfma_f32_32x32x16_bf16(PAF(1),VFR(5),o[1],0,0,0), C0,12); \
    KRD(GL,2); GAPB(o[0]=__builtin_amdgcn_mfma_f32_32x32x16_bf16(PAF(2),VFR(2),o[0],0,0,0), C1,0); \
    KRD(GL,3); GAPB(o[1]=__builtin_amdgcn_mfma_f32_32x32x16_bf16(PAF(2),VFR(6),o[1],0,0,0), C1,4); \
    GAPB(o[0]=__builtin_amdgcn_mfma_f32_32x32x16_bf16(PAF(3),VFR(3),o[0],0,0,0), C1,8); \
    GAPB(o[1]=__builtin_amdgcn_mfma_f32_32x32x16_bf16(PAF(3),VFR(7),o[1],0,0,0), C1,12); \
    }while(0)
  int t=1;
  #undef CMASK
  #define CMASK(P0,P1,t) do{}while(0)
  for(;t+5<NT;t+=2){
    STEP(pB0,pB1,pA0,pA1,t,true,true,true);     WAIT_BAR(2); RESC(); ROT();
    STEP(pA0,pA1,pB0,pB1,t+1,true,true,true);   WAIT_BAR(2); RESC(); ROT();
  }
  #undef CMASK
  #define CMASK(P0,P1,t) do{int jb_=(t)-(NT-4); if(jb_>=0)cmask(P0,P1,jb_,qrel,hi);}while(0)
  #define ENDW(tt) do{ if((tt)+3<NT){WAIT_BAR(2);} else if((tt)+2<NT){WAIT_BAR(1);} else {WAIT_BAR(0);} }while(0)
  for(;t+1<NT;t+=2){
    STEP(pB0,pB1,pA0,pA1,t,(t+3<NT),(t+1<NT),(t+1<NT));       ENDW(t);   RESC(); ROT();
    STEP(pA0,pA1,pB0,pB1,t+1,(t+4<NT),(t+2<NT),(t+2<NT));     ENDW(t+1); RESC(); ROT();
  }
  STEP(pB0,pB1,pA0,pA1,NT-1,false,false,false); RESC();
  { float sacc=pB0[0]+pB0[1]; _Pragma("unroll") for(int r=2;r<16;++r)sacc+=pB0[r]; _Pragma("unroll") for(int r=0;r<16;++r)sacc+=pB1[r]; l_reg+=sacc;
    pw0=(u32x4){PKW(pB0,0),PKW(pB0,2),PKW(pB0,4),PKW(pB0,6)};pw1=(u32x4){PKW(pB0,8),PKW(pB0,10),PKW(pB0,12),PKW(pB0,14)};pw2=(u32x4){PKW(pB1,0),PKW(pB1,2),PKW(pB1,4),PKW(pB1,6)};pw3=(u32x4){PKW(pB1,8),PKW(pB1,10),PKW(pB1,12),PKW(pB1,14)};
    SBAR(); pv(o,vb0+sl_cur,PAF(0),PAF(1),PAF(2),PAF(3)); }
  #undef PKW
  #undef PAF
  #undef VFR
  #undef PIN
  #undef MX3
  #undef GAPA
  #undef GAPB
  #undef EX
  #undef VRD
  #undef KRD
  #undef STEP
  #undef ENDW
  {auto rr=__builtin_amdgcn_permlane32_swap(__float_as_uint(l_reg),__float_as_uint(l_reg),false,false);l_reg=__uint_as_float(rr[0])+__uint_as_float(rr[1]);}
  if(hi==0)wsf[32+r32]=l_reg;asm volatile("s_waitcnt lgkmcnt(0)":::"memory");
  float rli[16];
  #pragma unroll
  for(int r=0;r<16;++r)rli[r]=__builtin_amdgcn_rcpf(wsf[32+crow(r,hi)]);
  bf16*Ow=O+(rowbase+q0+wid*QBLK)*DM+h*D;
  { bf16*stg=(bf16*)(shm+LDS_OST)+wid*2048;
    #pragma unroll
    for(int r=0;r<16;++r){const int orow=crow(r,hi);
      #pragma unroll
      for(int d0=0;d0<2;++d0)stg[orow*64+d0*32+r32]=__float2bfloat16(o[d0][r]*rli[r]);}
    asm volatile("s_waitcnt lgkmcnt(0)":::"memory");
    #pragma unroll
    for(int i=0;i<4;++i){const int row=i*8+(lane>>3),ch=lane&7; const u32x4 v=*(const u32x4*)(stg+row*64+ch*8); ATTN_STORE16(Ow+(long)row*DM+ch*8,v);} }
  asm volatile("s_waitcnt lgkmcnt(0)\n\ts_barrier":::"memory");
  #undef DMA_K
  #undef DMA_V
  #undef KB1
  #undef CMASK
  #undef START
  #undef RESC
  #undef ROT
}
constexpr int ATTN_LDS_BYTES=LDS_BYTES;
struct AttnTensors { const bf16* Q; const bf16* K; const bf16* V; bf16* O; };
struct AttnUnit { int bh; int qb; };
#undef SBAR
#undef WAIT_BAR
}
#define GAS __attribute__((address_space(1)))
#define LAS __attribute__((address_space(3)))
typedef unsigned short bf16;
typedef unsigned v4u __attribute__((ext_vector_type(4)));
typedef float f32x4 __attribute__((ext_vector_type(4)));
typedef short bf16x8 __attribute__((ext_vector_type(8)));
typedef GAS unsigned gu32;
typedef GAS unsigned long long gu64;
#define RLX_AGENT __ATOMIC_RELAXED, __HIP_MEMORY_SCOPE_AGENT
#define LDS_WAIT() asm volatile("s_waitcnt lgkmcnt(0)" ::: "memory")
#define VM_WAIT() asm volatile("s_waitcnt vmcnt(0)" ::: "memory")
__device__ __forceinline__ unsigned long long rt() { return __builtin_amdgcn_s_memrealtime(); }
__device__ __forceinline__ unsigned f2bf(float f) { unsigned u = __builtin_bit_cast(unsigned, f); return (u + 0x7fffu + ((u >> 16) & 1u)) >> 16; }
__device__ __forceinline__ unsigned pk2(float lo, float hi) { return f2bf(lo) | (f2bf(hi) << 16); }

#define XB_TMO      128
#define XB_XCNT(j)  (256  + 64 * (j))
#define XB_XSUB(j)  (1280 + 64 * (j))
#define XB_XGEN(j)  (2304 + 64 * (j))
#define XB_TOP      3328
#define XB_TOPGEN   3392
#define XCD_BAR_WORDS 3456
#define XB_SPIN_CAP (1u << 18)

__device__ __forceinline__ unsigned xb_ld(unsigned* p)              { return __hip_atomic_load(p, __ATOMIC_RELAXED, __HIP_MEMORY_SCOPE_AGENT); }
__device__ __forceinline__ unsigned xb_add(unsigned* p, unsigned v) { return __hip_atomic_fetch_add(p, v, __ATOMIC_RELAXED, __HIP_MEMORY_SCOPE_AGENT); }
__device__ __forceinline__ unsigned xb_xcc_id() { return (unsigned)__builtin_amdgcn_s_getreg((3 << 11) | 20) & 0xFu; }
#define XB_SPIN(cond, bar) do { unsigned _sp = 0; while (cond) { __builtin_amdgcn_s_sleep(1); \
    if ((++_sp & 255u) == 0u) { if (xb_ld(&(bar)[XB_TMO])) break; if (_sp > XB_SPIN_CAP) { atomicAdd(&(bar)[XB_TMO], 1u); break; } } } } while (0)

struct XcdBarrier {
    unsigned* bar; unsigned x;
    volatile LAS unsigned* st;
};

__device__ __forceinline__ XcdBarrier xcd_barrier_post(unsigned* bar, volatile LAS unsigned* st) {
    XcdBarrier b; b.bar = bar; b.x = xb_xcc_id(); b.st = st;
    if (threadIdx.x == 0) (void)xb_add(&bar[XB_XCNT(b.x)], 1u);
    return b;
}
__device__ __forceinline__ void xcd_barrier_complete(unsigned* bar, unsigned x, unsigned& nloc, unsigned& nx) {
    const unsigned G = gridDim.x * gridDim.y * gridDim.z;
    unsigned sum, cnt, mine, sp = 0u;
    for (;;) {
        sum = 0u; cnt = 0u; mine = 0u;
#pragma unroll
        for (unsigned j = 0; j < 16; ++j) { const unsigned c = xb_ld(&bar[XB_XCNT(j)]); sum += c; cnt += (c > 0u) ? 1u : 0u; mine = (j == x) ? c : mine; }
        if (sum == G) break;
        __builtin_amdgcn_s_sleep(1);
        if ((++sp & 255u) == 0u) { if (xb_ld(&bar[XB_TMO])) break; if (sp > XB_SPIN_CAP) { atomicAdd(&bar[XB_TMO], 1u); break; } }
    }
    nloc = mine > 0u ? mine : 1u; nx = cnt > 0u ? cnt : 1u;
}

__device__ __forceinline__ void xcd_barrier(const XcdBarrier& b) {
    asm volatile("s_waitcnt vmcnt(0)" ::: "memory");
    __syncthreads();
    if (threadIdx.x == 0) {
        unsigned* bar = b.bar;
        __builtin_amdgcn_s_waitcnt(0);
        unsigned nloc = b.st[0], nx = b.st[1];
        if (nloc == 0u) { xcd_barrier_complete(bar, b.x, nloc, nx); b.st[0] = nloc; b.st[1] = nx; }
        const unsigned old = xb_add(&bar[XB_XSUB(b.x)], 1u);
        const unsigned gen = old / nloc;
        if (old + 1u == (gen + 1u) * nloc) {
            __builtin_amdgcn_fence(__ATOMIC_RELEASE, "agent");
            asm volatile("s_waitcnt vmcnt(0)" ::: "memory");
            const unsigned og = xb_add(&bar[XB_TOP], 1u);
            const unsigned tg = og / nx;
            if (og + 1u == (tg + 1u) * nx) xb_add(&bar[XB_TOPGEN], 1u);
            else XB_SPIN(xb_ld(&bar[XB_TOPGEN]) == tg, bar);
            __builtin_amdgcn_fence(__ATOMIC_ACQUIRE, "agent");
            xb_add(&bar[XB_XGEN(b.x)], 1u);
            asm volatile("s_waitcnt vmcnt(0)" ::: "memory");
        } else {
            XB_SPIN(xb_ld(&bar[XB_XGEN(b.x)]) == gen, bar);
            __builtin_amdgcn_fence(__ATOMIC_ACQUIRE, "agent");
            asm volatile("s_waitcnt vmcnt(0)" ::: "memory");
        }
    }
    __syncthreads();
}
#include <hip/hip_cooperative_groups.h>
namespace cg = cooperative_groups;

#ifndef MK_MULTI
#define MK_MULTI 0
#endif

constexpr int NWAVES = 8, NTHR = 512;
constexpr int BATCH = 16, SEQ = 2048, D = 1024, M = BATCH * SEQ, NH = 16, FFH = 2816, MODW = 6 * D;
constexpr int INW = 3 * D + 16;
constexpr int NCH = SEQ / 64;
constexpr float EPS = 1e-6f, LOG2E = 1.4426950408889634f;

constexpr size_t MiB = 1u << 20;
constexpr size_t WS_CTL = 0, CTL_ZERO_BYTES = 1 * MiB;
constexpr size_t WS_WIN0 = 2 * MiB, WS_WOUT0 = 8 * MiB, WS_WIN1 = 10 * MiB, WS_WOUT1 = 16 * MiB;
constexpr size_t WS_FIN0 = 18 * MiB, WS_FIN1 = 29 * MiB, WS_FOUT0 = 40 * MiB, WS_FOUT1 = 46 * MiB;
constexpr size_t WS_MOD = 52 * MiB;
constexpr size_t WS_LOGF = 53 * MiB;
constexpr size_t WS_ALR = 55 * MiB;
constexpr size_t WS_DEC = 57 * MiB;
constexpr size_t WS_XN = 64 * MiB;
constexpr size_t WS_BIG = 128 * MiB;
constexpr size_t WS_GQI = 320 * MiB, WS_GKI = 352 * MiB, WS_GKDT = 384 * MiB, WS_GVT = 416 * MiB, WS_END = 480 * MiB;

constexpr int RING_BYTES = 131072;
constexpr int LDS_BYTES = 147456;

struct Args { const float* in[17]; float* out; unsigned char* ws; int ph_lo, ph_hi; };

struct Frame {
    LAS unsigned char* lds;
    int tid, lane, wave, vcu, G;
    const float *x, *c, *ada_w, *ada_b, *norm1_g, *norm2_g, *ffn_w_in, *ffn_w_out, *fox_w_in, *fox_b_f, *fox_w_out, *gla_w_in, *gla_w_a2, *gla_b_a, *gla_g_o, *gla_w_out, *final_g;
    float* out; unsigned char* ws;
    float *MOD, *LOGF, *ALR, *DEC;
    bf16 *XN, *BIG, *GQI, *GKI, *GKDT, *GVT;
};

__device__ __forceinline__ float wave_sum(float v) {
#pragma unroll
    for (int o = 1; o < 64; o <<= 1) v += __shfl_xor(v, o);
    return v;
}
__device__ __forceinline__ float bf2f(unsigned short h) { return __uint_as_float((unsigned)h << 16); }
__device__ __forceinline__ float log_sigmoid(float z) { return fminf(z, 0.f) - log1pf(__expf(-fabsf(z))); }
__device__ __forceinline__ float silu_f(float g) { return g * __builtin_amdgcn_rcpf(1.f + __expf(-g)); }

__device__ __forceinline__ void frame_tid(Frame& F) { int t = threadIdx.x; asm volatile("" : "+v"(t)); F.tid = t; F.lane = t & 63; F.wave = __builtin_amdgcn_readfirstlane(t >> 6); }
__device__ __forceinline__ void transpose_item(const float* W, int ldw, int K, bf16* WT, int k0, int n0, int drow0, LAS float* scr, int lane) {
#pragma unroll 8
    for (int i = 0; i < 32; ++i) { const int kk = 2 * i + (lane >> 5); scr[kk * 33 + (lane & 31)] = W[(size_t)(k0 + kk) * ldw + n0 + (lane & 31)]; }
    LDS_WAIT(); asm volatile("" ::: "memory");
    const int c = lane & 7;
#pragma unroll
    for (int j = 0; j < 4; ++j) { const int n = (lane >> 3) + 8 * j; const LAS float* s = scr + (8 * c) * 33 + n;
        v4u o; o.x = pk2(s[0 * 33], s[1 * 33]); o.y = pk2(s[2 * 33], s[3 * 33]); o.z = pk2(s[4 * 33], s[5 * 33]); o.w = pk2(s[6 * 33], s[7 * 33]);
        *(GAS v4u*)(WT + (size_t)(drow0 + n) * K + k0 + 8 * c) = o; }
    LDS_WAIT(); asm volatile("" ::: "memory");
}
__device__ __forceinline__ int ffn_in_row(int n0) { const int j = n0 < FFH ? n0 : n0 - FFH; return (j >> 7) * 256 + (n0 < FFH ? 0 : 128) + (j & 127); }

__device__ __forceinline__ void p0_prologue(Frame& F) {
    LAS float* cact = (LAS float*)F.lds;
    LAS float* red = (LAS float*)(F.lds + 65536);
    if (F.vcu < 192) {
        for (int e = F.tid; e < 16 * D; e += NTHR) { const int b = e >> 10, k = e & 1023; const float cv = F.c[e]; cact[k * 16 + b] = cv / (1.f + __expf(-cv)); }
        __syncthreads();
        for (int task = F.vcu; task < 192; task += F.G) {
            const int l = task / 96, j0 = (task % 96) * 64;
            const float* W = F.ada_w + (size_t)l * D * MODW + j0 + F.lane;
            float acc[16];
#pragma unroll
            for (int b = 0; b < 16; ++b) acc[b] = 0.f;
            const int kb = F.wave * 128;
#pragma unroll 4
            for (int kk = 0; kk < 128; ++kk) { const int k = kb + kk; const float wv = W[(size_t)k * MODW];
                const LAS f32x4* cp = (const LAS f32x4*)(cact + k * 16);
#pragma unroll
                for (int q = 0; q < 4; ++q) { const f32x4 cv = cp[q]; acc[4 * q + 0] += cv.x * wv; acc[4 * q + 1] += cv.y * wv; acc[4 * q + 2] += cv.z * wv; acc[4 * q + 3] += cv.w * wv; } }
#pragma unroll
            for (int b = 0; b < 16; ++b) red[(F.wave * 16 + b) * 64 + F.lane] = acc[b];
            __syncthreads();
            for (int o = F.tid; o < 1024; o += NTHR) { const int b = o >> 6, col = o & 63; float s = F.ada_b[l * MODW + j0 + col];
#pragma unroll
                for (int w = 0; w < 8; ++w) s += red[(w * 16 + b) * 64 + col];
                F.MOD[((size_t)l * 16 + b) * MODW + j0 + col] = s; }
            __syncthreads();
        }
    }
    __syncthreads();
    LAS float* scr = (LAS float*)(F.lds + F.wave * 16384);
    const int gw = F.vcu * NWAVES + F.wave, NGW = F.G * NWAVES;
    constexpr int I_IN = 16 * 96, I_OUT = 16 * 32, I_FI = 16 * 176, I_FO = 44 * 32;
    constexpr int NITEMS = 2 * I_IN + 2 * I_OUT + 2 * I_FI + 2 * I_FO;
    for (int it = gw; it < NITEMS; it += NGW) {
        int r = it;
        if (r < I_IN) { transpose_item(F.fox_w_in, INW, D, (bf16*)(F.ws + WS_WIN0), 64 * (r / 96), 32 * (r % 96), 32 * (r % 96), scr, F.lane); continue; } r -= I_IN;
        if (r < I_IN) { transpose_item(F.gla_w_in, INW, D, (bf16*)(F.ws + WS_WIN1), 64 * (r / 96), 32 * (r % 96), 32 * (r % 96), scr, F.lane); continue; } r -= I_IN;
        if (r < I_OUT) { transpose_item(F.fox_w_out, D, D, (bf16*)(F.ws + WS_WOUT0), 64 * (r / 32), 32 * (r % 32), 32 * (r % 32), scr, F.lane); continue; } r -= I_OUT;
        if (r < I_OUT) { transpose_item(F.gla_w_out, D, D, (bf16*)(F.ws + WS_WOUT1), 64 * (r / 32), 32 * (r % 32), 32 * (r % 32), scr, F.lane); continue; } r -= I_OUT;
        if (r < 2 * I_FI) { const int l = r / I_FI; r -= l * I_FI; const int n0 = 32 * (r % 176);
            transpose_item(F.ffn_w_in + (size_t)l * D * 2 * FFH, 2 * FFH, D, (bf16*)(F.ws + (l ? WS_FIN1 : WS_FIN0)), 64 * (r / 176), n0, ffn_in_row(n0), scr, F.lane); continue; } r -= 2 * I_FI;
        { const int l = r / I_FO; r -= l * I_FO;
            transpose_item(F.ffn_w_out + (size_t)l * FFH * D, D, FFH, (bf16*)(F.ws + (l ? WS_FOUT1 : WS_FOUT0)), 64 * (r / 32), 32 * (r % 32), 32 * (r % 32), scr, F.lane); }
    }
}

__device__ __forceinline__ float bfly32(float (&v)[32], int lane) {
#define BFLY_STEP(HALF, OFF) { const bool up = (lane & (OFF)) != 0; _Pragma("unroll") for (int i = 0; i < (HALF); ++i) { const float keep = up ? v[i + (HALF)] : v[i]; const float send = up ? v[i] : v[i + (HALF)]; v[i] = keep + __shfl_xor(send, (OFF)); } }
    BFLY_STEP(16, 32) BFLY_STEP(8, 16) BFLY_STEP(4, 8) BFLY_STEP(2, 4) BFLY_STEP(1, 2)
#undef BFLY_STEP
    return v[0] + __shfl_xor(v[0], 1);
}
__device__ __forceinline__ void norm_pass(Frame& F, const float* xin, const float* gvec, const float* modl, int shc, int mode, const float* wx) {
    LAS float* wT = (LAS float*)F.lds;
    if (mode != 2) {
        for (int e = F.tid; e < 16 * D; e += NTHR) { const int k = e >> 4, j = e & 15; wT[j * D + k] = wx[(size_t)k * INW + 3 * D + j]; }
    }
    __syncthreads();
    const int gw = F.vcu * NWAVES + F.wave, NGW = F.G * NWAVES, lane = F.lane;
    for (int r0 = gw * 16; r0 < M; r0 += NGW * 16) {
        const int b = r0 / SEQ;
        const float* mb = modl + (size_t)b * MODW;
        f32x4 wk[4], sk[4];
#pragma unroll
        for (int j = 0; j < 4; ++j) { const int k = 4 * lane + 256 * j; const f32x4 g = *(const f32x4*)(gvec + k), sc = *(const f32x4*)(mb + (shc + 1) * D + k);
            wk[j] = g * (sc + 1.0f); sk[j] = *(const f32x4*)(mb + shc * D + k); }
#pragma unroll 1
        for (int i = 0; i < 16; i += 2) {
            const int ra = r0 + i, rb = ra + 1;
            const GAS f32x4* xa = (const GAS f32x4*)(xin + (size_t)ra * D) + lane; const GAS f32x4* xb = (const GAS f32x4*)(xin + (size_t)rb * D) + lane;
            f32x4 va[4], vb[4]; float sa = 0.f, sb = 0.f;
#pragma unroll
            for (int j = 0; j < 4; ++j) { va[j] = xa[64 * j]; vb[j] = xb[64 * j]; }
#pragma unroll
            for (int j = 0; j < 4; ++j) { sa += (va[j].x * va[j].x + va[j].y * va[j].y) + (va[j].z * va[j].z + va[j].w * va[j].w); sb += (vb[j].x * vb[j].x + vb[j].y * vb[j].y) + (vb[j].z * vb[j].z + vb[j].w * vb[j].w); }
            const float ra_ = 1.0f / sqrtf(wave_sum(sa) * (1.f / D) + EPS), rb_ = 1.0f / sqrtf(wave_sum(sb) * (1.f / D) + EPS);
            GAS unsigned long long* oa = (GAS unsigned long long*)(F.XN + (size_t)ra * D) + lane; GAS unsigned long long* ob = (GAS unsigned long long*)(F.XN + (size_t)rb * D) + lane;
#pragma unroll
            for (int j = 0; j < 4; ++j) { va[j] = va[j] * ra_ * wk[j] + sk[j]; vb[j] = vb[j] * rb_ * wk[j] + sk[j];
                oa[64 * j] = (unsigned long long)pk2(va[j].x, va[j].y) | ((unsigned long long)pk2(va[j].z, va[j].w) << 32);
                ob[64 * j] = (unsigned long long)pk2(vb[j].x, vb[j].y) | ((unsigned long long)pk2(vb[j].z, vb[j].w) << 32); }
            if (mode != 2) {
                float acc[32];
#pragma unroll
                for (int hd = 0; hd < 16; ++hd) { float pa = 0.f, pb = 0.f;
#pragma unroll
                    for (int j = 0; j < 4; ++j) { const f32x4 w = *(const LAS f32x4*)(wT + hd * D + 4 * lane + 256 * j);
                        pa += (va[j].x * w.x + va[j].y * w.y) + (va[j].z * w.z + va[j].w * w.w); pb += (vb[j].x * w.x + vb[j].y * w.y) + (vb[j].z * w.z + vb[j].w * w.w); }
                    acc[hd] = pa; acc[16 + hd] = pb; if (hd & 1) asm volatile("" ::: "memory"); }
                const float tot = bfly32(acc, lane);
                const int idx = ((lane >> 5) & 1) * 16 + ((lane >> 4) & 1) * 8 + ((lane >> 3) & 1) * 4 + ((lane >> 2) & 1) * 2 + ((lane >> 1) & 1);
                if ((lane & 1) == 0) { const int row = (idx >= 16) ? rb : ra, hd = idx & 15;
                    if (mode == 0) F.LOGF[((size_t)(b * NH + hd)) * SEQ + (row - b * SEQ)] = log_sigmoid(tot + F.fox_b_f[hd]);
                    else F.ALR[(size_t)row * 16 + hd] = tot; }
            }
        }
    }
}
__device__ __forceinline__ void final_norm(Frame& F) {
    const int gw = F.vcu * NWAVES + F.wave, NGW = F.G * NWAVES, lane = F.lane;
    f32x4 g[4];
#pragma unroll
    for (int j = 0; j < 4; ++j) g[j] = *(const f32x4*)(F.final_g + 4 * lane + 256 * j);
    for (int m = gw; m < M; m += NGW) {
        GAS f32x4* xr = (GAS f32x4*)(F.out + (size_t)m * D) + lane; f32x4 v[4]; float s = 0.f;
#pragma unroll
        for (int j = 0; j < 4; ++j) { v[j] = xr[64 * j]; s += (v[j].x * v[j].x + v[j].y * v[j].y) + (v[j].z * v[j].z + v[j].w * v[j].w); }
        const float r = 1.0f / sqrtf(wave_sum(s) * (1.f / D) + EPS);
#pragma unroll
        for (int j = 0; j < 4; ++j) xr[64 * j] = v[j] * r * g[j];
    }
}
__device__ __forceinline__ void gla_onorm(Frame& F) {
    const int gw = F.vcu * NWAVES + F.wave, NGW = F.G * NWAVES, lane = F.lane;
    float go[16];
#pragma unroll
    for (int i = 0; i < 16; ++i) go[i] = F.gla_g_o[16 * lane + i];
    for (int m = gw; m < M; m += NGW) {
        const bf16* orow = F.BIG + (size_t)m * 3072 + 16 * lane;
        const v4u o0 = *(const GAS v4u*)orow, o1 = *(const GAS v4u*)(orow + 8), r0 = *(const GAS v4u*)(orow + 2048), r1 = *(const GAS v4u*)(orow + 2056);
        float ov[16], rv[16];
#pragma unroll
        for (int q = 0; q < 4; ++q) { ov[2 * q] = __uint_as_float(o0[q] << 16); ov[2 * q + 1] = __uint_as_float(o0[q] & 0xffff0000u); ov[8 + 2 * q] = __uint_as_float(o1[q] << 16); ov[8 + 2 * q + 1] = __uint_as_float(o1[q] & 0xffff0000u);
            rv[2 * q] = __uint_as_float(r0[q] << 16); rv[2 * q + 1] = __uint_as_float(r0[q] & 0xffff0000u); rv[8 + 2 * q] = __uint_as_float(r1[q] << 16); rv[8 + 2 * q + 1] = __uint_as_float(r1[q] & 0xffff0000u); }
        float ss = 0.f;
#pragma unroll
        for (int i = 0; i < 16; ++i) ss += ov[i] * ov[i];
        ss += __shfl_xor(ss, 1); ss += __shfl_xor(ss, 2); ss += __shfl_xor(ss, 4); ss += __shfl_xor(ss, 8);
        const float rs = 1.0f / sqrtf(ss * (1.f / 256.f) + EPS);
        v4u w0, w1;
#pragma unroll
        for (int q = 0; q < 4; ++q) {
            w0[q] = pk2(ov[2 * q] * rs * go[2 * q] * silu_f(rv[2 * q]), ov[2 * q + 1] * rs * go[2 * q + 1] * silu_f(rv[2 * q + 1]));
            w1[q] = pk2(ov[8 + 2 * q] * rs * go[8 + 2 * q] * silu_f(rv[8 + 2 * q]), ov[8 + 2 * q + 1] * rs * go[8 + 2 * q + 1] * silu_f(rv[8 + 2 * q + 1])); }
        bf16* xo = F.XN + (size_t)m * D + 16 * lane;
        *(GAS v4u*)xo = w0; *(GAS v4u*)(xo + 8) = w1;
    }
}

namespace pg8 {
struct EpiSwiGLU {
    static constexpr bool PERM = true, AFTER_DRAIN = false;
    bf16_t* O; int ldc;
    __device__ __forceinline__ void operator()(const f32x4 (&acc)[2][2][4][2], const Unit& u, int wr, int wc, int fr, int fq) const {
        const int row0 = u.pm * BM + wr * 64 + fr, col0 = u.pn * HALF + wc * 32 + 8 * fq;
#pragma unroll
        for (int ai = 0; ai < 2; ++ai)
#pragma unroll
            for (int m = 0; m < 4; ++m) { bf16_t* rowp = O + (size_t)(row0 + ai * HALF + m * 16) * ldc + col0;
                const f32x4 g0 = acc[ai][0][m][0], g1 = acc[ai][0][m][1], u0 = acc[ai][1][m][0], u1 = acc[ai][1][m][1];
                u32x4 w; w.x = cvt_pk_bf16(silu_f(g0[0]) * u0[0], silu_f(g0[1]) * u0[1]); w.y = cvt_pk_bf16(silu_f(g0[2]) * u0[2], silu_f(g0[3]) * u0[3]);
                w.z = cvt_pk_bf16(silu_f(g1[0]) * u1[0], silu_f(g1[1]) * u1[1]); w.w = cvt_pk_bf16(silu_f(g1[2]) * u1[2], silu_f(g1[3]) * u1[3]);
                *(u32x4*)rowp = w; }
    }
};
struct EpiResGate {
    static constexpr bool PERM = false, AFTER_DRAIN = false;
    const float* base; float* out; const float* gate;
    __device__ __forceinline__ void operator()(const f32x4 (&acc)[2][2][4][2], const Unit& u, int wr, int wc, int fr, int fq) const {
        const int row0 = u.pm * BM + wr * 64 + fr, col0 = u.pn * BM + wc * 32 + 4 * fq;
        const float* gp = gate + (size_t)((u.pm * BM) / SEQ) * MODW + col0;
        f32x4 gv[2][2];
#pragma unroll
        for (int bj = 0; bj < 2; ++bj)
#pragma unroll
            for (int n = 0; n < 2; ++n) gv[bj][n] = *(const f32x4*)(gp + bj * HALF + n * 16);
#pragma unroll
        for (int ai = 0; ai < 2; ++ai)
#pragma unroll
            for (int m = 0; m < 4; ++m) { const size_t off = (size_t)(row0 + ai * HALF + m * 16) * D + col0;
#pragma unroll
                for (int bj = 0; bj < 2; ++bj)
#pragma unroll
                    for (int n = 0; n < 2; ++n) { const f32x4 bs = *(const f32x4*)(base + off + bj * HALF + n * 16); *(f32x4*)(out + off + bj * HALF + n * 16) = bs + gv[bj][n] * acc[ai][bj][m][n]; } }
    }
};
}

constexpr int ATT_KB_OFF = 86016;
__device__ __forceinline__ void fox_attention(Frame& F, char* ldsg) {
    LAS float* kb = (LAS float*)(F.lds + ATT_KB_OFF);
    LAS float* wsum = (LAS float*)(F.lds + ATT_KB_OFF + 8192);
    const attn_body::bf16* Q = (const attn_body::bf16*)F.BIG; const attn_body::bf16* K = Q + (size_t)M * D; const attn_body::bf16* V = K + (size_t)M * D;
    for (int bh = F.vcu; bh < BATCH * NH; bh += F.G) {
        { const f32x4 v = *(const f32x4*)(F.LOGF + (size_t)bh * SEQ + 4 * F.tid);
          const float c0 = v.x, c1 = c0 + v.y, c2 = c1 + v.z, c3 = c2 + v.w;
          float inc = c3;
#pragma unroll
          for (int o = 1; o < 64; o <<= 1) { const float t = __shfl_up(inc, o); if (F.lane >= o) inc += t; }
          if (F.lane == 63) wsum[F.wave] = inc;
          __syncthreads();
          float off = 0.f;
#pragma unroll
          for (int w = 0; w < 8; ++w) { const float t = wsum[w]; if (w < F.wave) off += t; }
          const float ex = inc - c3 + off;
          *(LAS f32x4*)(kb + 4 * F.tid) = (f32x4){-(ex + c0) * LOG2E, -(ex + c1) * LOG2E, -(ex + c2) * LOG2E, -(ex + c3) * LOG2E};
          __syncthreads(); }
        const int b = bh / NH, h = bh % NH;
#pragma unroll 1
        for (int qb = SEQ / 256 - 1; qb >= 0; --qb) attn_body::attn_unit<8>(b, h, qb, Q, K, V, (attn_body::bf16*)F.BIG, ldsg, kb);
        __syncthreads();
    }
}

__device__ __forceinline__ void gla_prep(Frame& F) {
    LAS float* s_alr = (LAS float*)F.lds;
    LAS float* s_seg = (LAS float*)(F.lds + 4096);
    LAS unsigned short* s_v = (LAS unsigned short*)(F.lds + 8192);
    const int tid = F.tid;
    for (int it = F.vcu; it < BATCH * NCH * 4; it += F.G) {
        const int h = it & 3; const size_t m0 = (size_t)(it >> 2) * 64;
        if (tid < 256) ((LAS f32x4*)s_alr)[tid] = *(const f32x4*)(F.ALR + m0 * 16 + tid * 4);
        for (int p = tid; p < 2048; p += NTHR) { const int t = p >> 5, c = p & 31;
            *(LAS v4u*)(s_v + t * 264 + c * 8) = *(const GAS v4u*)(F.BIG + (m0 + t) * 3072 + 1024 + h * 256 + c * 8); }
        __syncthreads();
        const int kd = tid & 127, tq = tid >> 7;
        float w[16];
#pragma unroll
        for (int r = 0; r < 16; ++r) w[r] = F.gla_w_a2[r * 512 + h * 128 + kd];
        const float ba = F.gla_b_a[h * 128 + kd];
        float cs[16]; float run = 0.f;
#pragma unroll
        for (int tt = 0; tt < 16; ++tt) { const LAS f32x4* ap = (const LAS f32x4*)(s_alr + (16 * tq + tt) * 16); float z = ba;
#pragma unroll
            for (int q = 0; q < 4; ++q) { const f32x4 a = ap[q]; z += a.x * w[4 * q] + a.y * w[4 * q + 1] + a.z * w[4 * q + 2] + a.w * w[4 * q + 3]; }
            run += log_sigmoid(z) * (1.f / 16.f); cs[tt] = run; }
        s_seg[tq * 128 + kd] = run;
        __syncthreads();
        float off = 0.f, tot = 0.f;
#pragma unroll
        for (int q = 0; q < 4; ++q) { const float sv = s_seg[q * 128 + kd]; tot += sv; if (q < tq) off += sv; }
        const bf16* qp = F.BIG + (m0 + 16 * tq) * 3072 + h * 128 + kd; const bf16* kp = qp + 512;
        bf16* qo = F.GQI + (size_t)it * 8192 + (16 * tq) * 128 + kd; bf16* ko = F.GKI + (size_t)it * 8192 + (16 * tq) * 128 + kd;
        unsigned kdp[8];
#pragma unroll
        for (int tt = 0; tt < 16; ++tt) { const float bb = cs[tt] + off; const float q = bf2f(qp[(size_t)tt * 3072]), k = bf2f(kp[(size_t)tt * 3072]);
            qo[tt * 128] = (bf16)f2bf(q * 0.08838834764831845f * __expf(bb)); ko[tt * 128] = (bf16)f2bf(k * __expf(-bb));
            const unsigned kv = f2bf(k * __expf(tot - bb));
            if (tt & 1) kdp[tt >> 1] |= kv << 16; else kdp[tt >> 1] = kv; }
        { GAS v4u* dp = (GAS v4u*)(F.GKDT + (size_t)it * 8192 + kd * 64 + 16 * tq); dp[0] = (v4u){kdp[0], kdp[1], kdp[2], kdp[3]}; dp[1] = (v4u){kdp[4], kdp[5], kdp[6], kdp[7]}; }
        if (tq == 0) F.DEC[(size_t)it * 128 + kd] = __expf(tot);
        { const int vc = tid & 255, hf = tid >> 8; unsigned pk[16];
#pragma unroll
          for (int q = 0; q < 16; ++q) { const int t = 32 * hf + 2 * q; pk[q] = (unsigned)s_v[t * 264 + vc] | ((unsigned)s_v[(t + 1) * 264 + vc] << 16); }
          GAS v4u* dp = (GAS v4u*)(F.GVT + (size_t)it * 16384 + vc * 64 + 32 * hf);
#pragma unroll
          for (int q = 0; q < 4; ++q) dp[q] = (v4u){pk[4 * q], pk[4 * q + 1], pk[4 * q + 2], pk[4 * q + 3]}; }
        __syncthreads();
    }
}

__device__ __forceinline__ void gla_scan(Frame& F) {
    constexpr int P128 = 272, P64 = 144;
    constexpr int O_QI = 0, O_KI = O_QI + 64 * P128, O_KDT = O_KI + 64 * P128, O_VT = O_KDT + 128 * P64, O_A = O_VT + 64 * P64, O_ST0 = O_A + 64 * P64, O_ST1 = O_ST0 + 64 * P128, O_DEC = O_ST1 + 64 * P128;
    static_assert(O_DEC + 512 <= RING_BYTES, "gla_scan LDS");
    LAS unsigned char* lds = F.lds;
    const int tid = F.tid, lane = F.lane, w = F.wave, fr = lane & 15, fq = lane >> 4;
    typedef unsigned u32x2 __attribute__((ext_vector_type(2)));
#define MFMA16(a, b, c) __builtin_amdgcn_mfma_f32_16x16x32_bf16((a), (b), (c), 0, 0, 0)
    for (int u = F.vcu; u < 256; u += F.G) {
        const int bh = u >> 2, vs = u & 3, b = bh >> 2, h = bh & 3;
        for (int p = tid; p < (64 * P128) / 16; p += NTHR) *(LAS v4u*)(lds + O_ST0 + p * 16) = (v4u){0u, 0u, 0u, 0u};
        f32x4 S[4];
#pragma unroll
        for (int j = 0; j < 4; ++j) S[j] = (f32x4){0.f, 0.f, 0.f, 0.f};
        v4u rq[2], rk[2], rd[2], rv; float rdec = 0.f;
#define GS_LOAD(n) do { const size_t it_ = (size_t)((b * NCH + (n)) * 4 + h); \
        const GAS v4u* q_ = (const GAS v4u*)(F.GQI + it_ * 8192); const GAS v4u* k_ = (const GAS v4u*)(F.GKI + it_ * 8192); const GAS v4u* d_ = (const GAS v4u*)(F.GKDT + it_ * 8192); \
        rq[0] = q_[tid]; rq[1] = q_[tid + 512]; rk[0] = k_[tid]; rk[1] = k_[tid + 512]; rd[0] = d_[tid]; rd[1] = d_[tid + 512]; \
        rv = ((const GAS v4u*)(F.GVT + it_ * 16384 + vs * 4096))[tid]; if (tid < 128) rdec = F.DEC[it_ * 128 + tid]; } while (0)
        GS_LOAD(0);
#pragma unroll 1
        for (int n = 0; n < NCH; ++n) {
            __syncthreads();
#pragma unroll
            for (int i = 0; i < 2; ++i) { const int p = tid + 512 * i;
                *(LAS v4u*)(lds + O_QI + (p >> 4) * P128 + (p & 15) * 16) = rq[i]; *(LAS v4u*)(lds + O_KI + (p >> 4) * P128 + (p & 15) * 16) = rk[i];
                *(LAS v4u*)(lds + O_KDT + (p >> 3) * P64 + (p & 7) * 16) = rd[i]; }
            *(LAS v4u*)(lds + O_VT + (tid >> 3) * P64 + (tid & 7) * 16) = rv;
            if (tid < 128) ((LAS float*)(lds + O_DEC))[tid] = rdec;
            if (n + 1 < NCH) GS_LOAD(n + 1);
            __syncthreads();
            const int tb = w & 3, g2 = 2 * (w >> 2);
            bf16x8 qf[4];
#pragma unroll
            for (int kk = 0; kk < 4; ++kk) qf[kk] = *(const LAS bf16x8*)(lds + O_QI + (16 * tb + fr) * P128 + fq * 16 + kk * 64);
#pragma unroll
            for (int j = 0; j < 2; ++j) { const int sb = g2 + j; f32x4 a = (f32x4){0.f, 0.f, 0.f, 0.f};
#pragma unroll
                for (int kk = 0; kk < 4; ++kk) { const bf16x8 kf = *(const LAS bf16x8*)(lds + O_KI + (16 * sb + fr) * P128 + fq * 16 + kk * 64); a = MFMA16(kf, qf[kk], a); }
                const int t = 16 * tb + fr, s0 = 16 * sb + 4 * fq;
                u32x2 pkd; pkd.x = pk2(s0 + 0 <= t ? a[0] : 0.f, s0 + 1 <= t ? a[1] : 0.f); pkd.y = pk2(s0 + 2 <= t ? a[2] : 0.f, s0 + 3 <= t ? a[3] : 0.f);
                *(LAS u32x2*)(lds + O_A + t * P64 + s0 * 2) = pkd; }
            { const f32x4 dv = *(const LAS f32x4*)(lds + O_DEC + (16 * w + 4 * fq) * 4);
              bf16x8 af[2];
#pragma unroll
              for (int kk = 0; kk < 2; ++kk) af[kk] = *(const LAS bf16x8*)(lds + O_KDT + (16 * w + fr) * P64 + fq * 16 + kk * 64);
              const int stn = ((n + 1) & 1) ? O_ST1 : O_ST0;
#pragma unroll
              for (int j = 0; j < 4; ++j) { S[j] = S[j] * dv;
#pragma unroll
                  for (int kk = 0; kk < 2; ++kk) { const bf16x8 vf = *(const LAS bf16x8*)(lds + O_VT + (16 * j + fr) * P64 + fq * 16 + kk * 64); S[j] = MFMA16(af[kk], vf, S[j]); }
                  u32x2 pkd; pkd.x = pk2(S[j][0], S[j][1]); pkd.y = pk2(S[j][2], S[j][3]);
                  *(LAS u32x2*)(lds + stn + (16 * j + fr) * P128 + (16 * w + 4 * fq) * 2) = pkd; } }
            __syncthreads();
            { const int stc = (n & 1) ? O_ST1 : O_ST0;
              bf16x8 a2[2];
#pragma unroll
              for (int kk = 0; kk < 2; ++kk) a2[kk] = *(const LAS bf16x8*)(lds + O_A + (16 * tb + fr) * P64 + fq * 16 + kk * 64);
              const size_t mrow = (size_t)b * SEQ + n * 64 + 16 * tb + fr;
#pragma unroll
              for (int j = 0; j < 2; ++j) { const int vcb = g2 + j; f32x4 o = (f32x4){0.f, 0.f, 0.f, 0.f};
#pragma unroll
                  for (int kk = 0; kk < 2; ++kk) { const bf16x8 vf = *(const LAS bf16x8*)(lds + O_VT + (16 * vcb + fr) * P64 + fq * 16 + kk * 64); o = MFMA16(vf, a2[kk], o); }
#pragma unroll
                  for (int kk = 0; kk < 4; ++kk) { const bf16x8 sf = *(const LAS bf16x8*)(lds + stc + (16 * vcb + fr) * P128 + fq * 16 + kk * 64); o = MFMA16(sf, qf[kk], o); }
                  u32x2 pkd; pkd.x = pk2(o[0], o[1]); pkd.y = pk2(o[2], o[3]);
                  *(GAS u32x2*)(F.BIG + mrow * 3072 + h * 256 + vs * 64 + 16 * vcb + 4 * fq) = pkd; } }
        }
        __syncthreads();
    }
#undef GS_LOAD
#undef MFMA16
}

__global__ void __launch_bounds__(NTHR, 2) fwd_megakernel(Args args) {
    extern __shared__ __attribute__((aligned(16))) unsigned char lds[];
    Frame F;
    F.lds = (LAS unsigned char*)lds;
    F.tid = threadIdx.x; F.lane = F.tid & 63; F.wave = __builtin_amdgcn_readfirstlane(F.tid >> 6);
    F.G = gridDim.x; { const int bx = blockIdx.x; F.vcu = (F.G % 8 == 0) ? (bx % 8) * (F.G / 8) + bx / 8 : bx; }
    F.x = args.in[0]; F.c = args.in[1]; F.ada_w = args.in[2]; F.ada_b = args.in[3]; F.norm1_g = args.in[4]; F.norm2_g = args.in[5]; F.ffn_w_in = args.in[6]; F.ffn_w_out = args.in[7];
    F.fox_w_in = args.in[8]; F.fox_b_f = args.in[9]; F.fox_w_out = args.in[10]; F.gla_w_in = args.in[11]; F.gla_w_a2 = args.in[12]; F.gla_b_a = args.in[13]; F.gla_g_o = args.in[14]; F.gla_w_out = args.in[15]; F.final_g = args.in[16];
    F.out = args.out; F.ws = args.ws;
    unsigned char* ws = args.ws;
    F.MOD = (float*)(ws + WS_MOD); F.LOGF = (float*)(ws + WS_LOGF); F.ALR = (float*)(ws + WS_ALR); F.DEC = (float*)(ws + WS_DEC);
    F.XN = (bf16*)(ws + WS_XN); F.BIG = (bf16*)(ws + WS_BIG); F.GQI = (bf16*)(ws + WS_GQI); F.GKI = (bf16*)(ws + WS_GKI); F.GKDT = (bf16*)(ws + WS_GKDT); F.GVT = (bf16*)(ws + WS_GVT);
    const int lo = args.ph_lo, hi = args.ph_hi;
    bool first = true;
#if MK_MULTI
#define GRID_BAR() do {} while (0)
#else
#define GRID_BAR() cg::this_grid().sync()
#endif
#define PHASE(id) if (lo <= (id) && (id) < hi && ((first ? (void)0 : (void)(GRID_BAR())), first = false, frame_tid(F), true))

    PHASE(0) { p0_prologue(F); }
#pragma unroll 1
    for (int l = 0; l < 2; ++l) {
        const int pb = 1 + 9 * l;
        const float* modl = F.MOD + (size_t)l * 16 * MODW;
        const float* xcur = l == 0 ? F.x : F.out;
        PHASE(pb + 0) { norm_pass(F, xcur, F.norm1_g + l * D, modl, 0, l, l == 0 ? F.fox_w_in : F.gla_w_in); }
        PHASE(pb + 1) {
            pg8::Gemm g{F.XN, (const bf16*)(ws + (l ? WS_WIN1 : WS_WIN0)), M, 3 * D, D}; pg8::StaticOrder S; S.init(M, 3 * D, F.G, (int)blockIdx.x);
            pg8::EpiBf16<0> E{F.BIG, l == 0 ? D : 3 * D, nullptr, l == 0 ? D : 0, (size_t)M * D, attn_body::C2};
            pg8::gemm_phase<pg8::EpiBf16<0>, pg8::StaticOrder, PG8_ALIGN, PG8_SP2>(F.lds, g, S, E);
        }
        if (l == 0) {
            PHASE(pb + 2) { fox_attention(F, (char*)lds); }
        } else {
            PHASE(pb + 2) { gla_prep(F); }
            PHASE(pb + 3) { gla_scan(F); }
            PHASE(pb + 4) { gla_onorm(F); }
        }
        PHASE(pb + 5) {
            pg8::Gemm g{l == 0 ? F.BIG : F.XN, (const bf16*)(ws + (l ? WS_WOUT1 : WS_WOUT0)), M, D, D}; pg8::StaticOrder S; S.init(M, D, F.G, (int)blockIdx.x);
            pg8::EpiResGate E{xcur, F.out, modl + 2 * D};
            pg8::gemm_phase<pg8::EpiResGate, pg8::StaticOrder, PG8_ALIGN, PG8_SP2>(F.lds, g, S, E);
        }
        PHASE(pb + 6) { norm_pass(F, F.out, F.norm2_g + l * D, modl, 3, 2, nullptr); }
        PHASE(pb + 7) {
            pg8::Gemm g{F.XN, (const bf16*)(ws + (l ? WS_FIN1 : WS_FIN0)), M, 2 * FFH, D}; pg8::StaticOrder S; S.init(M, 2 * FFH, F.G, (int)blockIdx.x);
            pg8::EpiSwiGLU E{F.BIG, FFH};
            pg8::gemm_phase<pg8::EpiSwiGLU, pg8::StaticOrder, PG8_ALIGN, PG8_SP2>(F.lds, g, S, E);
        }
        PHASE(pb + 8) {
            pg8::Gemm g{F.BIG, (const bf16*)(ws + (l ? WS_FOUT1 : WS_FOUT0)), M, D, FFH}; pg8::StaticOrder S; S.init(M, D, F.G, (int)blockIdx.x);
            pg8::EpiResGate E{F.out, F.out, modl + 5 * D};
            pg8::gemm_phase<pg8::EpiResGate, pg8::StaticOrder, PG8_ALIGN, PG8_SP2>(F.lds, g, S, E);
        }
    }
    PHASE(19) { final_norm(F); }
#undef PHASE
}

constexpr int N_PHASES = 20;
extern "C" void kernel_launch(void* const* d_in, const int* in_sizes, int n_in, void* d_out, int out_size, void* d_ws, size_t ws_size, hipStream_t stream) {
    static int grid = 0;
    if (grid == 0) {
        if (n_in != 17 || in_sizes[0] != M * D || out_size != M * D || ws_size < WS_END) { fprintf(stderr, "kernel_launch: unexpected problem: n_in %d in0 %d out %d ws %zu (need %zu)\n", n_in, n_in > 0 ? in_sizes[0] : -1, out_size, ws_size, (size_t)WS_END); grid = -1; return; }
        int dev = 0, cus = 0, per_cu = 0;
        if (hipGetDevice(&dev) != hipSuccess || hipDeviceGetAttribute(&cus, hipDeviceAttributeMultiprocessorCount, dev) != hipSuccess) { grid = -1; return; }
        if (hipFuncSetAttribute((const void*)fwd_megakernel, hipFuncAttributeMaxDynamicSharedMemorySize, LDS_BYTES) != hipSuccess) { fprintf(stderr, "kernel_launch: hipFuncSetAttribute failed\n"); grid = -1; return; }
        if (hipOccupancyMaxActiveBlocksPerMultiprocessor(&per_cu, (const void*)fwd_megakernel, NTHR, LDS_BYTES) != hipSuccess || per_cu < 1) { fprintf(stderr, "kernel_launch: occupancy query says %d blocks/CU\n", per_cu); per_cu = 1; }
        (void)hipGetLastError();
        grid = cus * 1;
    }
    if (grid < 0) return;
    Args a{};
    for (int i = 0; i < 17; ++i) a.in[i] = (const float*)d_in[i];
    a.out = (float*)d_out; a.ws = (unsigned char*)d_ws;
#if MK_MULTI
    for (int p = 0; p < N_PHASES; ++p) { if (p == 4 || p == 5) continue; a.ph_lo = p; a.ph_hi = p + 1; hipLaunchKernelGGL(fwd_megakernel, dim3(grid), dim3(NTHR), LDS_BYTES, stream, a); }
#else
    a.ph_lo = 0; a.ph_hi = N_PHASES;
    void* kargs[] = {&a};
    const hipError_t e = hipLaunchCooperativeKernel((const void*)fwd_megakernel, dim3(grid), dim3(NTHR), kargs, LDS_BYTES, stream);
    if (e != hipSuccess) fprintf(stderr, "kernel_launch: cooperative launch failed: %s (grid %d)\n", hipGetErrorString(e), grid);
#endif
}
```

```cpp
#include <hip/hip_runtime.h>
#include <cstdio>
#include <cstdint>
namespace pg8 {
#define PG8_LAS __attribute__((address_space(3)))
typedef unsigned short bf16_t;
typedef short bf16x8 __attribute__((ext_vector_type(8)));
typedef float f32x4 __attribute__((ext_vector_type(4)));
typedef unsigned u32x4 __attribute__((ext_vector_type(4)));
constexpr int BM = 256, BK = 64, HALF = 128, HTB = HALF * BK * 2  , STAGE_BYTES = 8 * HTB, NXCD = 8, WGM = 8;

__host__ __device__ __forceinline__ int lds_byte(int r, int c) { const int st = (r >> 4) * 2 + (c >> 5), rr = r & 15, cc = c & 31, ob = rr * 64 + cc * 2; return st * 1024 + (ob ^ (((ob >> 9) & 1) << 5)); }
__host__ __device__ __forceinline__ void stage_rc(int b, int& R, int& C) { const int st = b / 1024, sb = b % 1024, swz = sb ^ (((sb >> 9) & 1) << 5); R = (st >> 1) * 16 + swz / 64; C = (st & 1) * 32 + (swz % 64) / 2; }
__host__ __device__ __forceinline__ int perm32(int rho) { const int n = rho >> 4, i = rho & 15; return 8 * (i >> 2) + 4 * n + (i & 3); }

struct Unit { int pm, pn; };
struct Gemm { const bf16_t* A; const bf16_t* Bt; int M, N, K; };

struct StaticOrder {
    int nM, nN, nwg, G, c;
    __host__ __device__ void init(int M, int N, int G_, int c_) { nM = M / BM; nN = N / BM; nwg = nM * nN; G = G_; c = c_; }
    __host__ __device__ bool next(int i, Unit& u) const {
        const long L = (long)i * G + c; if (L >= nwg) return false;
        int wgid = (int)L; { const int q = nwg / NXCD, r = nwg % NXCD, xcd = wgid % NXCD, off = wgid / NXCD; wgid = (xcd < r ? xcd * (q + 1) : r * (q + 1) + (xcd - r) * q) + off; }
        const int nig = WGM * nN, gid = wgid / nig, fm = gid * WGM, gsz = (nM - fm) < WGM ? (nM - fm) : WGM;
        u.pm = fm + ((wgid % nig) % gsz); u.pn = (wgid % nig) / gsz; return true;
    }
    __device__ __forceinline__ void a_ready(const Unit&) const {}
    __device__ __forceinline__ void done(const Unit&) const {}
};

__device__ __forceinline__ unsigned cvt_pk_bf16(float lo, float hi) { unsigned r; asm volatile("v_cvt_pk_bf16_f32 %0, %1, %2" : "=v"(r) : "v"(lo), "v"(hi)); return r; }
typedef float f32x2 __attribute__((ext_vector_type(2)));
__device__ __forceinline__ f32x2 gelu_pk(f32x2 v) {
    const f32x2 av = __builtin_elementwise_abs(v), d = av * 0.2316418882f + 1.0f;
    f32x2 t; t.x = __builtin_amdgcn_rcpf(d.x); t.y = __builtin_amdgcn_rcpf(d.y);
    f32x2 q = t * 0.5307027145f + (-0.7265760135f); q = q * t + 0.7107068705f; q = q * t + (-0.142248368f); q = q * t + 0.127414796f; q = q * t;
    const f32x2 s = (v * v) * (-0.72134752044f);
    f32x2 e; e.x = __builtin_amdgcn_exp2f(s.x); e.y = __builtin_amdgcn_exp2f(s.y);
    const f32x2 m = v * (q * e), r = v - m;
    f32x2 o; o.x = v.x < 0.f ? m.x : r.x; o.y = v.y < 0.f ? m.y : r.y; return o;
}

template <int ACT  > struct EpiBf16 {
    static constexpr bool PERM = true, AFTER_DRAIN = false; static_assert(ACT == 0 || ACT == 1, "EpiBf16: ACT is 0 (none) or 1 (gelu_pk)");
    bf16_t* O; int ldc; const float* bias; int split_cols; size_t split_stride; float scale0;
    __device__ __forceinline__ void operator()(const f32x4 (&acc)[2][2][4][2], const Unit& u, int wr, int wc, int fr, int fq) const {
        const int row0 = u.pm * BM + wr * 64 + fr; int colt = u.pn * BM; bf16_t* base = O;
        float sc = 1.f; if (split_cols) { const int t = colt / split_cols; base += (size_t)t * split_stride; colt -= t * split_cols; if (t == 0) sc = scale0; }
        const int col0 = colt + wc * 32 + 8 * fq, bcol0 = u.pn * BM + wc * 32 + 8 * fq;
        f32x4 bv[2][2];
#pragma unroll
        for (int bj = 0; bj < 2; ++bj)
#pragma unroll
            for (int n = 0; n < 2; ++n) bv[bj][n] = bias ? *(const f32x4*)(bias + bcol0 + bj * HALF + 4 * n) : (f32x4){0.f, 0.f, 0.f, 0.f};
#pragma unroll
        for (int ai = 0; ai < 2; ++ai)
#pragma unroll
            for (int m = 0; m < 4; ++m) { bf16_t* rowp = base + (size_t)(row0 + ai * HALF + m * 16) * ldc + col0;
#pragma unroll
                for (int bj = 0; bj < 2; ++bj) { f32x4 v0 = acc[ai][bj][m][0] + bv[bj][0], v1 = acc[ai][bj][m][1] + bv[bj][1];
                    if (ACT == 1) { f32x2 a = gelu_pk((f32x2){v0[0], v0[1]}), b = gelu_pk((f32x2){v0[2], v0[3]}), c = gelu_pk((f32x2){v1[0], v1[1]}), d = gelu_pk((f32x2){v1[2], v1[3]});
                        v0 = (f32x4){a.x, a.y, b.x, b.y}; v1 = (f32x4){c.x, c.y, d.x, d.y}; }
                    v0 = v0 * sc; v1 = v1 * sc; u32x4 w; w.x = cvt_pk_bf16(v0[0], v0[1]); w.y = cvt_pk_bf16(v0[2], v0[3]); w.z = cvt_pk_bf16(v1[0], v1[1]); w.w = cvt_pk_bf16(v1[2], v1[3]);
                    *(u32x4*)(rowp + bj * HALF) = w; } }
    }
};

template <class Epi, class Sched, bool ALIGN_EPI = false, bool SP2 = false>
__device__ __forceinline__ void gemm_phase(PG8_LAS unsigned char* lds, const Gemm g, const Sched& S, const Epi& E) {
    int tid_ = threadIdx.x; asm volatile("" : "+v"(tid_));
    const int tid = tid_, wid = __builtin_amdgcn_readfirstlane(tid >> 6), lane = tid & 63, wr = wid >> 2, wc = wid & 3, fr = lane & 15, fq = lane >> 4;
    const int K = g.K, nt = K / BK;
    unsigned voffA[2], voffB[2];
#pragma unroll
    for (int i = 0; i < 2; ++i) { int R, C; stage_rc(tid * 16 + i * 8192, R, C); const int Rb = Epi::PERM ? ((R & ~31) + perm32(R & 31)) : R;
        voffA[i] = (unsigned)(R * K + C) * 2u; voffB[i] = (unsigned)(Rb * K + C) * 2u; }
    const size_t kstep = (size_t)(BK * 2);
    const size_t hstep = (size_t)HALF * K * 2;
    const size_t tstep = 2 * hstep;
    const unsigned ldsw = (unsigned)wid * 1024u;
    const int aoff = lds_byte(wr * 64 + fr, fq * 8), boff = lds_byte(wc * 32 + fr, fq * 8);
#define PG8_SA(b, h) (((b) * 2 + (h)) * HTB)
#define PG8_SB(b, h) ((4 + (b) * 2 + (h)) * HTB)
#define PG8_STAGE(bufoff, gbase, voff) do { _Pragma("unroll") for (int _i = 0; _i < 2; ++_i) \
        __builtin_amdgcn_global_load_lds((const unsigned*)((const char*)(gbase) + (voff)[_i]), (PG8_LAS unsigned*)(lds + (bufoff) + ldsw + _i * 8192), 16, 0, 0); } while (0)
#define PG8_LDA(dst, b, h) do { _Pragma("unroll") for (int m = 0; m < 4; ++m) _Pragma("unroll") for (int k = 0; k < 2; ++k) dst[m][k] = *(const PG8_LAS bf16x8*)(lds + PG8_SA(b, h) + aoff + m * 2048 + k * 1024); } while (0)
#define PG8_LDB(dst, b, h) do { _Pragma("unroll") for (int n = 0; n < 2; ++n) _Pragma("unroll") for (int k = 0; k < 2; ++k) dst[n][k] = *(const PG8_LAS bf16x8*)(lds + PG8_SB(b, h) + boff + n * 2048 + k * 1024); } while (0)
#define PG8_MMA(ai, bj, At, Bt) do { __builtin_amdgcn_s_setprio(1); _Pragma("unroll") for (int m = 0; m < 4; ++m) _Pragma("unroll") for (int n = 0; n < 2; ++n) _Pragma("unroll") for (int k = 0; k < 2; ++k) \
        acc[ai][bj][m][n] = __builtin_amdgcn_mfma_f32_16x16x32_bf16(Bt[n][k], At[m][k], acc[ai][bj][m][n], 0, 0, 0); __builtin_amdgcn_s_setprio(0); } while (0)
#define PG8_WAIT_V(n) asm volatile("s_waitcnt vmcnt(" #n ")" ::: "memory")
#define PG8_WAIT_L(n) asm volatile("s_waitcnt lgkmcnt(" #n ")" ::: "memory")
#define PG8_BAR __builtin_amdgcn_s_barrier()
#define PG8_SCHED __builtin_amdgcn_sched_barrier(0)
    Unit cur, nxt; int ui = 0;
    if (!S.next(0, cur)) return;
    f32x4 acc[2][2][4][2];
#pragma unroll
    for (int a = 0; a < 2; ++a)
#pragma unroll
        for (int b = 0; b < 2; ++b)
#pragma unroll
            for (int m = 0; m < 4; ++m)
#pragma unroll
                for (int n = 0; n < 2; ++n) acc[a][b][m][n] = (f32x4){0.f, 0.f, 0.f, 0.f};
    bf16x8 At[4][2], B0[2][2], B1[2][2];
    const char* cA = (const char*)g.A + (size_t)cur.pm * tstep; const char* cB = (const char*)g.Bt + (size_t)cur.pn * tstep;
    S.a_ready(cur);
    if constexpr (SP2) {
        PG8_STAGE(PG8_SB(0, 0), cB, voffB); PG8_STAGE(PG8_SB(0, 1), cB + hstep, voffB); PG8_STAGE(PG8_SA(0, 0), cA, voffA); PG8_STAGE(PG8_SA(0, 1), cA + hstep, voffA);
        if (wr == 1) PG8_BAR;
        PG8_WAIT_V(2); PG8_BAR;
        PG8_STAGE(PG8_SB(1, 0), cB + kstep, voffB); PG8_STAGE(PG8_SA(1, 0), cA + kstep, voffA); PG8_STAGE(PG8_SB(1, 1), cB + hstep + kstep, voffB);
        PG8_WAIT_V(6); PG8_BAR;
    } else {
        PG8_STAGE(PG8_SB(0, 0), cB, voffB); PG8_STAGE(PG8_SA(0, 0), cA, voffA); PG8_STAGE(PG8_SB(0, 1), cB + hstep, voffB); PG8_STAGE(PG8_SA(0, 1), cA + hstep, voffA);
        if (wr == 1) PG8_BAR;
        PG8_WAIT_V(4); PG8_BAR;
        PG8_STAGE(PG8_SB(1, 0), cB + kstep, voffB); PG8_STAGE(PG8_SA(1, 0), cA + kstep, voffA); PG8_STAGE(PG8_SB(1, 1), cB + hstep + kstep, voffB);
        PG8_WAIT_V(6); PG8_BAR;
    }
    for (;;) {
        const bool has_next = S.next(ui + 1, nxt);
        const char* nA = has_next ? (const char*)g.A + (size_t)nxt.pm * tstep : cA; const char* nB = has_next ? (const char*)g.Bt + (size_t)nxt.pn * tstep : cB;
        for (int t = 0; t < nt; t += 2) {
            const bool last = (t == nt - 2);
            const char* a1 = cA + (size_t)(t + 1) * kstep;
            const char* a2 = last ? nA : cA + (size_t)(t + 2) * kstep; const char* b2 = last ? nB : cB + (size_t)(t + 2) * kstep;
            const char* a3 = a2 + kstep; const char* b3 = b2 + kstep;
            if (last && has_next) S.a_ready(nxt);
            if constexpr (SP2) {
            PG8_LDB(B0, 0, 0); PG8_LDB(B1, 0, 1); PG8_SCHED; PG8_LDA(At, 0, 0); PG8_STAGE(PG8_SA(1, 1), a1 + hstep, voffA);
            PG8_WAIT_V(8); PG8_WAIT_L(0); PG8_BAR; PG8_MMA(0, 0, At, B0); PG8_MMA(0, 1, At, B1); PG8_BAR; PG8_SCHED;
            PG8_LDA(At, 0, 1); PG8_STAGE(PG8_SB(0, 0), b2, voffB); PG8_STAGE(PG8_SB(0, 1), b2 + hstep, voffB); PG8_STAGE(PG8_SA(0, 0), a2, voffA);
            PG8_WAIT_V(8); PG8_WAIT_L(0); PG8_BAR; PG8_MMA(1, 0, At, B0); PG8_MMA(1, 1, At, B1); PG8_BAR; PG8_SCHED;
            PG8_LDB(B0, 1, 0); PG8_LDB(B1, 1, 1); PG8_SCHED; PG8_LDA(At, 1, 0); PG8_STAGE(PG8_SA(0, 1), a2 + hstep, voffA);
            PG8_WAIT_V(8); PG8_WAIT_L(0); PG8_BAR; PG8_MMA(0, 0, At, B0); PG8_MMA(0, 1, At, B1); PG8_BAR; PG8_SCHED;
            PG8_LDA(At, 1, 1); PG8_STAGE(PG8_SB(1, 0), b3, voffB); PG8_STAGE(PG8_SB(1, 1), b3 + hstep, voffB); PG8_STAGE(PG8_SA(1, 0), a3, voffA);
            PG8_WAIT_V(8); PG8_WAIT_L(0); PG8_BAR; PG8_MMA(1, 0, At, B0); PG8_MMA(1, 1, At, B1); PG8_BAR; PG8_SCHED;
            } else {
            PG8_LDB(B0, 0, 0); PG8_SCHED; PG8_LDA(At, 0, 0); PG8_STAGE(PG8_SA(1, 1), a1 + hstep, voffA);
            PG8_WAIT_L(8); PG8_BAR; PG8_WAIT_L(0); PG8_MMA(0, 0, At, B0); PG8_BAR; PG8_SCHED;
            PG8_LDB(B1, 0, 1); PG8_STAGE(PG8_SB(0, 0), b2, voffB);
            PG8_BAR; PG8_WAIT_L(0); PG8_MMA(0, 1, At, B1); PG8_BAR;
            PG8_LDA(At, 0, 1); PG8_STAGE(PG8_SA(0, 0), a2, voffA);
            PG8_BAR; PG8_WAIT_L(0); PG8_MMA(1, 0, At, B0); PG8_BAR; PG8_SCHED;
            PG8_STAGE(PG8_SB(0, 1), b2 + hstep, voffB);
            PG8_WAIT_V(6); PG8_BAR; PG8_MMA(1, 1, At, B1); PG8_BAR;
            PG8_LDB(B0, 1, 0); PG8_SCHED; PG8_LDA(At, 1, 0); PG8_STAGE(PG8_SA(0, 1), a2 + hstep, voffA);
            PG8_WAIT_L(8); PG8_BAR; PG8_WAIT_L(0); PG8_MMA(0, 0, At, B0); PG8_BAR; PG8_SCHED;
            PG8_LDB(B1, 1, 1); PG8_STAGE(PG8_SB(1, 0), b3, voffB);
            PG8_BAR; PG8_WAIT_L(0); PG8_MMA(0, 1, At, B1); PG8_BAR;
            PG8_LDA(At, 1, 1); PG8_STAGE(PG8_SA(1, 0), a3, voffA);
            PG8_BAR; PG8_WAIT_L(0); PG8_MMA(1, 0, At, B0); PG8_BAR; PG8_SCHED;
            PG8_STAGE(PG8_SB(1, 1), b3 + hstep, voffB);
            PG8_WAIT_V(6); PG8_BAR; PG8_MMA(1, 1, At, B1); PG8_BAR;
            }
        }
        if constexpr (ALIGN_EPI) { if (wr == 0) PG8_BAR; }
        if constexpr (!Epi::AFTER_DRAIN) { E(acc, cur, wr, wc, fr, fq); S.done(cur); }
        if (!has_next) break;
#pragma unroll
        for (int a = 0; a < 2; ++a)
#pragma unroll
            for (int b = 0; b < 2; ++b)
#pragma unroll
                for (int m = 0; m < 4; ++m)
#pragma unroll
                    for (int n = 0; n < 2; ++n) acc[a][b][m][n] = (f32x4){0.f, 0.f, 0.f, 0.f};
        cur = nxt; cA = nA; cB = nB; ++ui;
        if constexpr (ALIGN_EPI) { if (wr == 1) PG8_BAR; }
    }
    PG8_WAIT_V(0);
    if constexpr (!ALIGN_EPI) { if (wr == 0) PG8_BAR; }
    PG8_BAR;
    if constexpr (Epi::AFTER_DRAIN) { E.fused(acc, cur, wr, wc, fr, fq, lds, wid, lane); S.done(cur); }
#undef PG8_SA
#undef PG8_SB
#undef PG8_STAGE
#undef PG8_LDA
#undef PG8_LDB
#undef PG8_MMA
#undef PG8_WAIT_V
#undef PG8_WAIT_L
#undef PG8_BAR
#undef PG8_SCHED
}
}

#ifndef PG8_SP2
#define PG8_SP2 true
#endif
#ifndef PG8_ALIGN
#define PG8_ALIGN true
#endif
#include <hip/hip_bf16.h>
#include <cmath>
namespace attn_body {
using bf16=__hip_bfloat16;
using bf16x8=__attribute__((ext_vector_type(8)))short;
using s16x4=__attribute__((ext_vector_type(4)))short;
using f32x16=__attribute__((ext_vector_type(16)))float;
using u32x4=__attribute__((ext_vector_type(4)))unsigned;
constexpr int BATCH=16,NHEAD=16,SEQ=2048,D=64,DM=NHEAD*D;
constexpr int NW=8,QBLK=32,QB=QBLK*NW,KVBLK=64,NQB=SEQ/QB;
constexpr int ATTN_PITCH=DM, ATTN_UNIT_ROWS=QB;
__device__ __forceinline__ int crow(int r,int hi){return (r&3)+8*(r>>2)+4*hi;}
#define SBAR() __builtin_amdgcn_sched_barrier(0)
__device__ __forceinline__ void cmask(f32x16&p0,f32x16&p1,int jb,int qrel,int hi){
  const float NEG=-INFINITY; int kb=64*jb+4*hi;
  #pragma unroll
  for(int r=0;r<16;++r){int kv=kb+(r&3)+8*(r>>2); if(kv>qrel)p0[r]=NEG; if(kv+32>qrel)p1[r]=NEG;}
}

constexpr int NSLOT=3, SLOTB=8192;
constexpr int LDS_K=0, LDS_V=NSLOT*SLOTB, LDS_WS=2*NSLOT*SLOTB, LDS_OST=LDS_WS+NW*64*4, LDS_BYTES=LDS_OST+NW*4096;
constexpr float C2=0.125f*1.4426950408889634f;
__device__ __forceinline__ void glds16(const void*gsrc,unsigned lds_dst){unsigned keep;
  asm volatile("s_mov_b32 %0, m0\n\ts_mov_b32 m0, %2\n\ts_nop 0\n\tglobal_load_lds_dwordx4 %1, off\n\ts_mov_b32 m0, %0":"=&s"(keep):"v"(gsrc),"s"(lds_dst):"memory");}
__device__ __forceinline__ float max3f(float a,float b,float c){float r;asm("v_max3_f32 %0, %1, %2, %3":"=v"(r):"v"(a),"v"(b),"v"(c));return r;}
__device__ __forceinline__ float max2f(float a,float b){float r;asm("v_max_f32_e32 %0, %1, %2":"=v"(r):"v"(a),"v"(b));return r;}
__device__ __forceinline__ float fadd_s(float a,float b){float r;asm("v_add_f32_e32 %0, %1, %2":"=v"(r):"v"(a),"v"(b));return r;}
__device__ __forceinline__ float fsub_s(float a,float b){float r;asm("v_sub_f32_e32 %0, %1, %2":"=v"(r):"v"(a),"v"(b));return r;}
typedef float f32x2_t __attribute__((ext_vector_type(2))); typedef __bf16 bf16x2_t __attribute__((ext_vector_type(2)));
__device__ __forceinline__ unsigned cvtpk_s(float lo,float hi){f32x2_t v={lo,hi};bf16x2_t b=__builtin_convertvector(v,bf16x2_t);return __builtin_bit_cast(unsigned,b);}
#define WAIT_BAR(N) asm volatile("s_waitcnt vmcnt(" #N ") lgkmcnt(0)\n\ts_barrier":::"memory")

__device__ __forceinline__ void qkt(f32x16&p0,f32x16&p1,const char*Kslot,const bf16x8*qr,const f32x16&c0,const f32x16&c1,int r32,int hi){
  const char*kb=Kslot+hi*1024+r32*16;
  #pragma unroll
  for(int d0=0;d0<4;++d0){
    const bf16x8 b0=*reinterpret_cast<const bf16x8*>(kb+d0*2048);
    const bf16x8 b1=*reinterpret_cast<const bf16x8*>(kb+d0*2048+512);
    if(d0==0){p0=__builtin_amdgcn_mfma_f32_32x32x16_bf16(b0,qr[0],c0,0,0,0);p1=__builtin_amdgcn_mfma_f32_32x32x16_bf16(b1,qr[0],c1,0,0,0);}
    else{p0=__builtin_amdgcn_mfma_f32_32x32x16_bf16(b0,qr[d0],p0,0,0,0);p1=__builtin_amdgcn_mfma_f32_32x32x16_bf16(b1,qr[d0],p1,0,0,0);}}
}
typedef __attribute__((address_space(3))) const char* lds_cptr;
typedef short v4i16_t __attribute__((ext_vector_type(4)));
__device__ __forceinline__ void kload8(bf16x8*kf,lds_cptr kp){
  kf[0]=*(const __attribute__((address_space(3))) bf16x8*)(kp);      kf[1]=*(const __attribute__((address_space(3))) bf16x8*)(kp+512);
  kf[2]=*(const __attribute__((address_space(3))) bf16x8*)(kp+2048); kf[3]=*(const __attribute__((address_space(3))) bf16x8*)(kp+2560);
  kf[4]=*(const __attribute__((address_space(3))) bf16x8*)(kp+4096); kf[5]=*(const __attribute__((address_space(3))) bf16x8*)(kp+4608);
  kf[6]=*(const __attribute__((address_space(3))) bf16x8*)(kp+6144); kf[7]=*(const __attribute__((address_space(3))) bf16x8*)(kp+6656);
}
__device__ __forceinline__ void kload2(bf16x8*kf,lds_cptr kp,int j){ kf[2*j]=*(const __attribute__((address_space(3))) bf16x8*)(kp+j*2048); kf[2*j+1]=*(const __attribute__((address_space(3))) bf16x8*)(kp+j*2048+512); }
__device__ __forceinline__ s16x4 vtr(lds_cptr p){ return __builtin_bit_cast(s16x4,__builtin_amdgcn_ds_read_tr16_b64_v4i16((__attribute__((address_space(3))) v4i16_t*)p)); }
__device__ __forceinline__ float rowmax(const f32x16&p0,const f32x16&p1){
  float a=max3f(p0[0],p0[1],p1[0]),b=max3f(p0[2],p0[3],p1[1]);a=max3f(a,p1[2],p1[3]);
  #pragma unroll
  for(int r=4;r<16;r+=4){a=max3f(a,p0[r],p0[r+1]);b=max3f(b,p0[r+2],p0[r+3]);a=max3f(a,p1[r],p1[r+1]);b=max3f(b,p1[r+2],p1[r+3]);}
  const float m=max2f(a,b);
  auto rr=__builtin_amdgcn_permlane32_swap(__float_as_uint(m),__float_as_uint(m),false,false);
  return max2f(__uint_as_float(rr[0]),__uint_as_float(rr[1]));
}
__device__ __forceinline__ void pv(f32x16*o,int vb,bf16x8 pa0,bf16x8 pa1,bf16x8 pa2,bf16x8 pa3){
  #pragma unroll
  for(int d0=0;d0<2;++d0){s16x4 lo[4],hi[4];
    #pragma unroll
    for(int ks=0;ks<4;++ks){
      asm volatile("ds_read_b64_tr_b16 %0,%1 offset:%c2":"=&v"(lo[ks]):"v"(vb),"i"(d0*4096+ks*1024):"memory");
      asm volatile("ds_read_b64_tr_b16 %0,%1 offset:%c2":"=&v"(hi[ks]):"v"(vb),"i"(d0*4096+ks*1024+512):"memory");}
    asm volatile("s_waitcnt lgkmcnt(0)":::"memory");SBAR();
    #define PK(k) (bf16x8){lo[k][0],lo[k][1],lo[k][2],lo[k][3],hi[k][0],hi[k][1],hi[k][2],hi[k][3]}
    o[d0]=__builtin_amdgcn_mfma_f32_32x32x16_bf16(pa0,PK(0),o[d0],0,0,0);
    o[d0]=__builtin_amdgcn_mfma_f32_32x32x16_bf16(pa1,PK(1),o[d0],0,0,0);
    o[d0]=__builtin_amdgcn_mfma_f32_32x32x16_bf16(pa2,PK(2),o[d0],0,0,0);
    o[d0]=__builtin_amdgcn_mfma_f32_32x32x16_bf16(pa3,PK(3),o[d0],0,0,0);
    #undef PK
  }
}

#ifndef ATTN_STORE16
#define ATTN_STORE16(p,v) (*(u32x4*)(p)=(v))
#endif
template<int THRL> __device__ __forceinline__ void attn_unit(int b,int h,int qb,const bf16*Q,const bf16*__restrict__ K,const bf16*__restrict__ V,bf16*O,char*shm,const __attribute__((address_space(3))) float*kbl){
  int tid_=threadIdx.x; asm volatile("":"+v"(tid_)); const int tid=tid_,lane=tid&63,r32=lane&31,hi=lane>>5; const int wid=__builtin_amdgcn_readfirstlane(tid>>6);
  const long rowbase=(long)b*SEQ; const int q0=qb*QB;
  const bf16*Qw=Q+(rowbase+q0+wid*QBLK)*DM+h*D;
  const bf16*Kh=K+rowbase*DM+h*D,*Vh=V+rowbase*DM+h*D;
  const unsigned lds0=(unsigned)(uintptr_t)shm;
  float*wsf=(float*)(shm+LDS_WS)+wid*64;
  const bf16*ksrc=Kh+(long)lane*DM+wid*8;
  const bf16*vsrc=Vh+(long)(16*(wid&3)+(lane>>2))*DM+(wid>>2)*32+(lane&3)*8;
  const unsigned kdst=lds0+LDS_K+wid*1024, vdst=lds0+LDS_V+wid*1024;
  #define DMA_K(t,slot) glds16(ksrc+(long)(t)*KVBLK*DM,(unsigned)__builtin_amdgcn_readfirstlane(kdst+(slot)))
  #define DMA_V(t,slot) glds16(vsrc+(long)(t)*KVBLK*DM,(unsigned)__builtin_amdgcn_readfirstlane(vdst+(slot)))
  const int vb0=(int)(lds0+LDS_V)+((lane>>4)&1)*32+(lane&3)*8+(4*hi+((lane&15)>>2))*64;
  const char*Kbase=shm+LDS_K; bf16x8 kf[8];
  const lds_cptr shm3=(lds_cptr)shm; const lds_cptr kp0=shm3+LDS_K+hi*1024+r32*16; const lds_cptr vp0=shm3+LDS_V+((lane>>4)&1)*32+(lane&3)*8+(4*hi+((lane&15)>>2))*64;
  const int NT=(q0+QB)/KVBLK;
  DMA_K(0,0);DMA_V(0,0);DMA_K(1,SLOTB);
  bf16x8 qr[4];
  #pragma unroll
  for(int d0=0;d0<4;++d0)qr[d0]=*reinterpret_cast<const bf16x8*>(&Qw[(long)r32*DM+d0*16+hi*8]);
  float mhat=0.f,l_reg=0.f;f32x16 o[2];o[0]=f32x16{};o[1]=f32x16{};float nm=0.f;
  const int qrel=wid*QBLK+r32;
  typedef float kb4_t __attribute__((ext_vector_type(4)));
  #define KB1(C,t,o) do{ const __attribute__((address_space(3))) float*kp_=kbl+64*(t)+4*hi+(o); \
    _Pragma("unroll") for(int j_=0;j_<4;++j_){ const kb4_t a_=*(const __attribute__((address_space(3))) kb4_t*)(kp_+8*j_); \
      _Pragma("unroll") for(int i_=0;i_<4;++i_){ C[4*j_+i_]=a_[i_]+nm; } } }while(0)
  #define CMASK(P0,P1,t) do{int jb_=(t)-(NT-4); if(jb_>=0)cmask(P0,P1,jb_,qrel,hi);}while(0)
  bool resc=false;
  #define START(P0,P1) do{ const float rm=rowmax(P0,P1); resc=false; \
    { const float dl=rm; mhat=fadd_s(mhat,dl); \
      _Pragma("unroll") for(int r=0;r<16;++r){P0[r]=fsub_s(P0[r],dl);P1[r]=fsub_s(P1[r],dl);} \
      nm=-mhat; } \
    _Pragma("unroll") for(int r=0;r<16;++r)P0[r]=__builtin_amdgcn_exp2f(P0[r]); }while(0)
  #define RESC() do{ if(resc){ asm volatile("s_waitcnt lgkmcnt(0)":::"memory"); \
      _Pragma("unroll") for(int d_=0;d_<2;++d_) _Pragma("unroll") for(int r=0;r<16;++r)o[d_][r]*=wsf[crow(r,hi)]; } }while(0)
  f32x16 pA0,pA1,pB0,pB1;
  int sl_prev=0,sl_cur=0,sl_next=SLOTB;
  #define ROT() do{sl_prev=sl_cur;sl_cur=sl_next;sl_next=(sl_next==(NSLOT-1)*SLOTB)?0:sl_next+SLOTB;}while(0)
  DMA_K(2,2*SLOTB);
  WAIT_BAR(3);
  { f32x16 cz0,cz1; KB1(cz0,0,0); KB1(cz1,0,32); qkt(pA0,pA1,Kbase,qr,cz0,cz1,r32,hi); } asm volatile("s_nop 15\n\ts_nop 7":"+v"(pA0),"+v"(pA1));CMASK(pA0,pA1,0);
  START(pA0,pA1);
  _Pragma("unroll") for(int r=0;r<16;++r)pA1[r]=__builtin_amdgcn_exp2f(pA1[r]);
  WAIT_BAR(0);
  DMA_K(3,0);DMA_V(1,SLOTB);
  ROT();
  kload8(kf,kp0+sl_cur);
  WAIT_BAR(2);
  s16x4 vlo[8],vhi[8]; u32x4 pw0,pw1,pw2,pw3;
  #define PKW(P,B) cvtpk_s(P[B],P[B+1])
  #define PAF(k) __builtin_bit_cast(bf16x8,pw##k)
  #define VFR(i) (bf16x8){vlo[i][0],vlo[i][1],vlo[i][2],vlo[i][3],vhi[i][0],vhi[i][1],vhi[i][2],vhi[i][3]}
  #define PIN(x) asm volatile("":"+v"(x))
  #define MX3(a,b,c) __builtin_fmaxf(__builtin_fmaxf((a),(b)),(c))
  #define GAPA(MF,A0,A1,A2,A3,W0,W1,PW) do{ MF; sacc+=A0; sacc+=A1; sacc+=A2; sacc+=A3; PIN(sacc); W0; W1; PIN(PW); SBAR(); }while(0)
  #define EX(v) __builtin_amdgcn_exp2f(v)
  #define GAPB(MF,X,B) do{ MF; X[B]=EX(X[B]); X[B+1]=EX(X[B+1]); X[B+2]=EX(X[B+2]); X[B+3]=EX(X[B+3]); PIN(X); SBAR(); }while(0)
  #define VRD(i) do{ vlo[i]=vtr(vp_+(((i)>>2)*4096+((i)&3)*1024)); vhi[i]=vtr(vp_+(((i)>>2)*4096+((i)&3)*1024+512)); }while(0)
  #define KRD(G,j) do{ if(G){ kload2(kf,kp0+sl_next,j); SBAR(); } }while(0)
  #define STEP(C0,C1,P0,P1,t,GK,GV,GL) do{ SBAR(); \
    const lds_cptr vp_=vp0+sl_prev; KB1(C0,t,0); SBAR(); \
    VRD(0); SBAR(); float sacc=(P0[0]+P0[1]); \
    GAPA(C0=__builtin_amdgcn_mfma_f32_32x32x16_bf16(kf[0],qr[0],C0,0,0,0), P0[2],P0[3],P0[4],P0[5],     pw0[0]=PKW(P0,0), pw0[1]=PKW(P0,2), pw0); \
    KB1(C1,t,32); VRD(4); SBAR(); GAPA(C1=__builtin_amdgcn_mfma_f32_32x32x16_bf16(kf[1],qr[0],C1,0,0,0), P0[6],P0[7],P0[8],P0[9],     pw0[2]=PKW(P0,4), pw0[3]=PKW(P0,6), pw0); \
    VRD(1); SBAR(); GAPA(C0=__builtin_amdgcn_mfma_f32_32x32x16_bf16(kf[2],qr[1],C0,0,0,0),   P0[10],P0[11],P0[12],P0[13], pw1[0]=PKW(P0,8), pw1[1]=PKW(P0,10), pw1); \
    VRD(5); SBAR(); GAPA(C1=__builtin_amdgcn_mfma_f32_32x32x16_bf16(kf[3],qr[1],C1,0,0,0),   P0[14],P0[15],P1[0],P1[1],   pw1[2]=PKW(P0,12),pw1[3]=PKW(P0,14), pw1); \
    VRD(2); SBAR(); GAPA(C0=__builtin_amdgcn_mfma_f32_32x32x16_bf16(kf[4],qr[2],C0,0,0,0),   P1[2],P1[3],P1[4],P1[5],     pw2[0]=PKW(P1,0), pw2[1]=PKW(P1,2), pw2); \
    VRD(6); SBAR(); GAPA(C1=__builtin_amdgcn_mfma_f32_32x32x16_bf16(kf[5],qr[2],C1,0,0,0),   P1[6],P1[7],P1[8],P1[9],     pw2[2]=PKW(P1,4), pw2[3]=PKW(P1,6), pw2); \
    VRD(3); SBAR(); GAPA(C0=__builtin_amdgcn_mfma_f32_32x32x16_bf16(kf[6],qr[3],C0,0,0,0),   P1[10],P1[11],P1[12],P1[13], pw3[0]=PKW(P1,8), pw3[1]=PKW(P1,10), pw3); \
    VRD(7); SBAR(); GAPA(C1=__builtin_amdgcn_mfma_f32_32x32x16_bf16(kf[7],qr[3],C1,0,0,0),   P1[14],P1[15],0.f,0.f,       pw3[2]=PKW(P1,12),pw3[3]=PKW(P1,14), pw3); \
    l_reg+=sacc; \
    if(GK){DMA_K((t)+3,sl_cur);} if(GV){DMA_V((t)+1,sl_next);} \
    CMASK(C0,C1,t); \
    { float a=MX3(C0[0],C0[1],C1[0]),b=MX3(C0[2],C0[3],C1[1]); a=MX3(a,C1[2],C1[3]); \
      _Pragma("unroll") for(int r=4;r<16;r+=4){a=MX3(a,C0[r],C0[r+1]);b=MX3(b,C0[r+2],C0[r+3]);a=MX3(a,C1[r],C1[r+1]);b=MX3(b,C1[r+2],C1[r+3]);} \
      float rm=__builtin_fmaxf(a,b); { auto rr=__builtin_amdgcn_permlane32_swap(__float_as_uint(rm),__float_as_uint(rm),false,false); rm=__builtin_fmaxf(__uint_as_float(rr[0]),__uint_as_float(rr[1])); } \
      resc=false; \
      if(__builtin_expect(__any(rm>(float)THRL),0)){ const float dl=__builtin_fmaxf(rm,0.f); mhat+=dl; \
        _Pragma("unroll") for(int r=0;r<16;++r){C0[r]-=dl;C1[r]-=dl;} \
        nm=-mhat; \
        const float f=__builtin_amdgcn_exp2f(-dl); l_reg*=f; if(hi==0)wsf[r32]=f; resc=true; } } \
    SBAR(); \
    GAPB(o[0]=__builtin_amdgcn_mfma_f32_32x32x16_bf16(PAF(0),VFR(0),o[0],0,0,0), C0,0); \
    GAPB(o[1]=__builtin_amdgcn_mfma_f32_32x32x16_bf16(PAF(0),VFR(4),o[1],0,0,0), C0,4); \
    KRD(GL,0); GAPB(o[0]=__builtin_amdgcn_mfma_f32_32x32x16_bf16(PAF(1),VFR(1),o[0],0,0,0), C0,8); \
    KRD(GL,1); GAPB(o[1]=__builtin_amdgcn_mfma_f32_32x32x16_bf16(PAF(1),VFR(5),o[1],0,0,0), C0,12); \
    KRD(GL,2); GAPB(o[0]=__builtin_amdgcn_mfma_f32_32x32x16_bf16(PAF(2),VFR(2),o[0],0,0,0), C1,0); \
    KRD(GL,3); GAPB(o[1]=__builtin_amdgcn_mfma_f32_32x32x16_bf16(PAF(2),VFR(6),o[1],0,0,0), C1,4); \
    GAPB(o[0]=__builtin_amdgcn_mfma_f32_32x32x16_bf16(PAF(3),VFR(3),o[0],0,0,0), C1,8); \
    GAPB(o[1]=__builtin_amdgcn_mfma_f32_32x32x16_bf16(PAF(3),VFR(7),o[1],0,0,0), C1,12); \
    }while(0)
  int t=1;
  #undef CMASK
  #define CMASK(P0,P1,t) do{}while(0)
  for(;t+5<NT;t+=2){
    STEP(pB0,pB1,pA0,pA1,t,true,true,true);     WAIT_BAR(2); RESC(); ROT();
    STEP(pA0,pA1,pB0,pB1,t+1,true,true,true);   WAIT_BAR(2); RESC(); ROT();
  }
  #undef CMASK
  #define CMASK(P0,P1,t) do{int jb_=(t)-(NT-4); if(jb_>=0)cmask(P0,P1,jb_,qrel,hi);}while(0)
  #define ENDW(tt) do{ if((tt)+3<NT){WAIT_BAR(2);} else if((tt)+2<NT){WAIT_BAR(1);} else {WAIT_BAR(0);} }while(0)
  for(;t+1<NT;t+=2){
    STEP(pB0,pB1,pA0,pA1,t,(t+3<NT),(t+1<NT),(t+1<NT));       ENDW(t);   RESC(); ROT();
    STEP(pA0,pA1,pB0,pB1,t+1,(t+4<NT),(t+2<NT),(t+2<NT));     ENDW(t+1); RESC(); ROT();
  }
  STEP(pB0,pB1,pA0,pA1,NT-1,false,false,false); RESC();
  { float sacc=pB0[0]+pB0[1]; _Pragma("unroll") for(int r=2;r<16;++r)sacc+=pB0[r]; _Pragma("unroll") for(int r=0;r<16;++r)sacc+=pB1[r]; l_reg+=sacc;
    pw0=(u32x4){PKW(pB0,0),PKW(pB0,2),PKW(pB0,4),PKW(pB0,6)};pw1=(u32x4){PKW(pB0,8),PKW(pB0,10),PKW(pB0,12),PKW(pB0,14)};pw2=(u32x4){PKW(pB1,0),PKW(pB1,2),PKW(pB1,4),PKW(pB1,6)};pw3=(u32x4){PKW(pB1,8),PKW(pB1,10),PKW(pB1,12),PKW(pB1,14)};
    SBAR(); pv(o,vb0+sl_cur,PAF(0),PAF(1),PAF(2),PAF(3)); }
  #undef PKW
  #undef PAF
  #undef VFR
  #undef PIN
  #undef MX3
  #undef GAPA
  #undef GAPB
  #undef EX
  #undef VRD
  #undef KRD
  #undef STEP
  #undef ENDW
  {auto rr=__builtin_amdgcn_permlane32_swap(__float_as_uint(l_reg),__float_as_uint(l_reg),false,false);l_reg=__uint_as_float(rr[0])+__uint_as_float(rr[1]);}
  if(hi==0)wsf[32+r32]=l_reg;asm volatile("s_waitcnt lgkmcnt(0)":::"memory");
  float rli[16];
  #pragma unroll
  for(int r=0;r<16;++r)rli[r]=__builtin_amdgcn_rcpf(wsf[32+crow(r,hi)]);
  bf16*Ow=O+(rowbase+q0+wid*QBLK)*DM+h*D;
  { bf16*stg=(bf16*)(shm+LDS_OST)+wid*2048;
    #pragma unroll
    for(int r=0;r<16;++r){const int orow=crow(r,hi);
      #pragma unroll
      for(int d0=0;d0<2;++d0)stg[orow*64+d0*32+r32]=__float2bfloat16(o[d0][r]*rli[r]);}
    asm volatile("s_waitcnt lgkmcnt(0)":::"memory");
    #pragma unroll
    for(int i=0;i<4;++i){const int row=i*8+(lane>>3),ch=lane&7; const u32x4 v=*(const u32x4*)(stg+row*64+ch*8); ATTN_STORE16(Ow+(long)row*DM+ch*8,v);} }
  asm volatile("s_waitcnt lgkmcnt(0)\n\ts_barrier":::"memory");
  #undef DMA_K
  #undef DMA_V
  #undef KB1
  #undef CMASK
  #undef START
  #undef RESC
  #undef ROT
}
constexpr int ATTN_LDS_BYTES=LDS_BYTES;
struct AttnTensors { const bf16* Q; const bf16* K; const bf16* V; bf16* O; };
struct AttnUnit { int bh; int qb; };
#undef SBAR
#undef WAIT_BAR
}
#define GAS __attribute__((address_space(1)))
#define LAS __attribute__((address_space(3)))
typedef unsigned short bf16;
typedef unsigned v4u __attribute__((ext_vector_type(4)));
typedef float f32x4 __attribute__((ext_vector_type(4)));
typedef short bf16x8 __attribute__((ext_vector_type(8)));
typedef GAS unsigned gu32;
typedef GAS unsigned long long gu64;
#define RLX_AGENT __ATOMIC_RELAXED, __HIP_MEMORY_SCOPE_AGENT
#define LDS_WAIT() asm volatile("s_waitcnt lgkmcnt(0)" ::: "memory")
#define VM_WAIT() asm volatile("s_waitcnt vmcnt(0)" ::: "memory")
__device__ __forceinline__ unsigned long long rt() { return __builtin_amdgcn_s_memrealtime(); }
__device__ __forceinline__ unsigned f2bf(float f) { unsigned u = __builtin_bit_cast(unsigned, f); return (u + 0x7fffu + ((u >> 16) & 1u)) >> 16; }
__device__ __forceinline__ unsigned pk2(float lo, float hi) { return f2bf(lo) | (f2bf(hi) << 16); }

#define XB_TMO      128
#define XB_XCNT(j)  (256  + 64 * (j))
#define XB_XSUB(j)  (1280 + 64 * (j))
#define XB_XGEN(j)  (2304 + 64 * (j))
#define XB_TOP      3328
#define XB_TOPGEN   3392
#define XCD_BAR_WORDS 3456
#define XB_SPIN_CAP (1u << 18)

__device__ __forceinline__ unsigned xb_ld(unsigned* p)              { return __hip_atomic_load(p, __ATOMIC_RELAXED, __HIP_MEMORY_SCOPE_AGENT); }
__device__ __forceinline__ unsigned xb_add(unsigned* p, unsigned v) { return __hip_atomic_fetch_add(p, v, __ATOMIC_RELAXED, __HIP_MEMORY_SCOPE_AGENT); }
__device__ __forceinline__ unsigned xb_xcc_id() { return (unsigned)__builtin_amdgcn_s_getreg((3 << 11) | 20) & 0xFu; }
#define XB_SPIN(cond, bar) do { unsigned _sp = 0; while (cond) { __builtin_amdgcn_s_sleep(1); \
    if ((++_sp & 255u) == 0u) { if (xb_ld(&(bar)[XB_TMO])) break; if (_sp > XB_SPIN_CAP) { atomicAdd(&(bar)[XB_TMO], 1u); break; } } } } while (0)

struct XcdBarrier {
    unsigned* bar; unsigned x;
    volatile LAS unsigned* st;
};

__device__ __forceinline__ XcdBarrier xcd_barrier_post(unsigned* bar, volatile LAS unsigned* st) {
    XcdBarrier b; b.bar = bar; b.x = xb_xcc_id(); b.st = st;
    if (threadIdx.x == 0) (void)xb_add(&bar[XB_XCNT(b.x)], 1u);
    return b;
}
__device__ __forceinline__ void xcd_barrier_complete(unsigned* bar, unsigned x, unsigned& nloc, unsigned& nx) {
    const unsigned G = gridDim.x * gridDim.y * gridDim.z;
    unsigned sum, cnt, mine, sp = 0u;
    for (;;) {
        sum = 0u; cnt = 0u; mine = 0u;
#pragma unroll
        for (unsigned j = 0; j < 16; ++j) { const unsigned c = xb_ld(&bar[XB_XCNT(j)]); sum += c; cnt += (c > 0u) ? 1u : 0u; mine = (j == x) ? c : mine; }
        if (sum == G) break;
        __builtin_amdgcn_s_sleep(1);
        if ((++sp & 255u) == 0u) { if (xb_ld(&bar[XB_TMO])) break; if (sp > XB_SPIN_CAP) { atomicAdd(&bar[XB_TMO], 1u); break; } }
    }
    nloc = mine > 0u ? mine : 1u; nx = cnt > 0u ? cnt : 1u;
}

__device__ __forceinline__ void xcd_barrier(const XcdBarrier& b) {
    asm volatile("s_waitcnt vmcnt(0)" ::: "memory");
    __syncthreads();
    if (threadIdx.x == 0) {
        unsigned* bar = b.bar;
        __builtin_amdgcn_s_waitcnt(0);
        unsigned nloc = b.st[0], nx = b.st[1];
        if (nloc == 0u) { xcd_barrier_complete(bar, b.x, nloc, nx); b.st[0] = nloc; b.st[1] = nx; }
        const unsigned old = xb_add(&bar[XB_XSUB(b.x)], 1u);
        const unsigned gen = old / nloc;
        if (old + 1u == (gen + 1u) * nloc) {
            __builtin_amdgcn_fence(__ATOMIC_RELEASE, "agent");
            asm volatile("s_waitcnt vmcnt(0)" ::: "memory");
            const unsigned og = xb_add(&bar[XB_TOP], 1u);
            const unsigned tg = og / nx;
            if (og + 1u == (tg + 1u) * nx) xb_add(&bar[XB_TOPGEN], 1u);
            else XB_SPIN(xb_ld(&bar[XB_TOPGEN]) == tg, bar);
            __builtin_amdgcn_fence(__ATOMIC_ACQUIRE, "agent");
            xb_add(&bar[XB_XGEN(b.x)], 1u);
            asm volatile("s_waitcnt vmcnt(0)" ::: "memory");
        } else {
            XB_SPIN(xb_ld(&bar[XB_XGEN(b.x)]) == gen, bar);
            __builtin_amdgcn_fence(__ATOMIC_ACQUIRE, "agent");
            asm volatile("s_waitcnt vmcnt(0)" ::: "memory");
        }
    }
    __syncthreads();
}
#include <hip/hip_cooperative_groups.h>
namespace cg = cooperative_groups;

#ifndef MK_MULTI
#define MK_MULTI 0
#endif

constexpr int NWAVES = 8, NTHR = 512;
constexpr int BATCH = 16, SEQ = 2048, D = 1024, M = BATCH * SEQ, NH = 16, FFH = 2816, MODW = 6 * D;
constexpr int INW = 3 * D + 16;
constexpr int NCH = SEQ / 64;
constexpr float EPS = 1e-6f, LOG2E = 1.4426950408889634f;

constexpr size_t MiB = 1u << 20;
constexpr size_t WS_CTL = 0, CTL_ZERO_BYTES = 1 * MiB;
constexpr size_t WS_WIN0 = 2 * MiB, WS_WOUT0 = 8 * MiB, WS_WIN1 = 10 * MiB, WS_WOUT1 = 16 * MiB;
constexpr size_t WS_FIN0 = 18 * MiB, WS_FIN1 = 29 * MiB, WS_FOUT0 = 40 * MiB, WS_FOUT1 = 46 * MiB;
constexpr size_t WS_MOD = 52 * MiB;
constexpr size_t WS_LOGF = 53 * MiB;
constexpr size_t WS_ALR = 55 * MiB;
constexpr size_t WS_DEC = 57 * MiB;
constexpr size_t WS_XN = 64 * MiB;
constexpr size_t WS_BIG = 128 * MiB;
constexpr size_t WS_GQI = 320 * MiB, WS_GKI = 352 * MiB, WS_GKDT = 384 * MiB, WS_GVT = 416 * MiB, WS_END = 480 * MiB;

constexpr int RING_BYTES = 131072;
constexpr int MISC_OFF = RING_BYTES + 320;
constexpr int CW_BAR = 4096;
constexpr int LDS_BYTES = 147456;

struct Args { const float* in[17]; float* out; unsigned char* ws; int ph_lo, ph_hi; };

struct Frame {
    LAS unsigned char* lds;
    int tid, lane, wave, vcu, G;
    const float *x, *c, *ada_w, *ada_b, *norm1_g, *norm2_g, *ffn_w_in, *ffn_w_out, *fox_w_in, *fox_b_f, *fox_w_out, *gla_w_in, *gla_w_a2, *gla_b_a, *gla_g_o, *gla_w_out, *final_g;
    float* out; unsigned char* ws;
    float *MOD, *LOGF, *ALR, *DEC;
    bf16 *XN, *BIG, *GQI, *GKI, *GKDT, *GVT;
};

__device__ __forceinline__ float wave_sum(float v) {
#pragma unroll
    for (int o = 1; o < 64; o <<= 1) v += __shfl_xor(v, o);
    return v;
}
__device__ __forceinline__ float bf2f(unsigned short h) { return __uint_as_float((unsigned)h << 16); }
__device__ __forceinline__ float log_sigmoid(float z) { return fminf(z, 0.f) - log1pf(__expf(-fabsf(z))); }
__device__ __forceinline__ float silu_f(float g) { return g * __builtin_amdgcn_rcpf(1.f + __expf(-g)); }

__device__ __forceinline__ void frame_tid(Frame& F) { int t = threadIdx.x; asm volatile("" : "+v"(t)); F.tid = t; F.lane = t & 63; F.wave = __builtin_amdgcn_readfirstlane(t >> 6); }
__device__ __forceinline__ void transpose_item(const float* W, int ldw, int K, bf16* WT, int k0, int n0, int drow0, LAS float* scr, int lane) {
#pragma unroll 8
    for (int i = 0; i < 32; ++i) { const int kk = 2 * i + (lane >> 5); scr[kk * 33 + (lane & 31)] = W[(size_t)(k0 + kk) * ldw + n0 + (lane & 31)]; }
    LDS_WAIT(); asm volatile("" ::: "memory");
    const int c = lane & 7;
#pragma unroll
    for (int j = 0; j < 4; ++j) { const int n = (lane >> 3) + 8 * j; const LAS float* s = scr + (8 * c) * 33 + n;
        v4u o; o.x = pk2(s[0 * 33], s[1 * 33]); o.y = pk2(s[2 * 33], s[3 * 33]); o.z = pk2(s[4 * 33], s[5 * 33]); o.w = pk2(s[6 * 33], s[7 * 33]);
        *(GAS v4u*)(WT + (size_t)(drow0 + n) * K + k0 + 8 * c) = o; }
    LDS_WAIT(); asm volatile("" ::: "memory");
}
__device__ __forceinline__ int ffn_in_row(int n0) { const int j = n0 < FFH ? n0 : n0 - FFH; return (j >> 7) * 256 + (n0 < FFH ? 0 : 128) + (j & 127); }

__device__ __forceinline__ void p0_prologue(Frame& F) {
    LAS float* cact = (LAS float*)F.lds;
    LAS float* red = (LAS float*)(F.lds + 65536);
    if (F.vcu < 192) {
        for (int e = F.tid; e < 16 * D; e += NTHR) { const int b = e >> 10, k = e & 1023; const float cv = F.c[e]; cact[k * 16 + b] = cv / (1.f + __expf(-cv)); }
        __syncthreads();
        for (int task = F.vcu; task < 192; task += F.G) {
            const int l = task / 96, j0 = (task % 96) * 64;
            const float* W = F.ada_w + (size_t)l * D * MODW + j0 + F.lane;
            float acc[16];
#pragma unroll
            for (int b = 0; b < 16; ++b) acc[b] = 0.f;
            const int kb = F.wave * 128;
#pragma unroll 4
            for (int kk = 0; kk < 128; ++kk) { const int k = kb + kk; const float wv = W[(size_t)k * MODW];
                const LAS f32x4* cp = (const LAS f32x4*)(cact + k * 16);
#pragma unroll
                for (int q = 0; q < 4; ++q) { const f32x4 cv = cp[q]; acc[4 * q + 0] += cv.x * wv; acc[4 * q + 1] += cv.y * wv; acc[4 * q + 2] += cv.z * wv; acc[4 * q + 3] += cv.w * wv; } }
#pragma unroll
            for (int b = 0; b < 16; ++b) red[(F.wave * 16 + b) * 64 + F.lane] = acc[b];
            __syncthreads();
            for (int o = F.tid; o < 1024; o += NTHR) { const int b = o >> 6, col = o & 63; float s = F.ada_b[l * MODW + j0 + col];
#pragma unroll
                for (int w = 0; w < 8; ++w) s += red[(w * 16 + b) * 64 + col];
                F.MOD[((size_t)l * 16 + b) * MODW + j0 + col] = s; }
            __syncthreads();
        }
    }
    __syncthreads();
    LAS float* scr = (LAS float*)(F.lds + F.wave * 16384);
    const int gw = F.vcu * NWAVES + F.wave, NGW = F.G * NWAVES;
    constexpr int I_IN = 16 * 96, I_OUT = 16 * 32, I_FI = 16 * 176, I_FO = 44 * 32;
    constexpr int NITEMS = 2 * I_IN + 2 * I_OUT + 2 * I_FI + 2 * I_FO;
    for (int it = gw; it < NITEMS; it += NGW) {
        int r = it;
        if (r < I_IN) { transpose_item(F.fox_w_in, INW, D, (bf16*)(F.ws + WS_WIN0), 64 * (r / 96), 32 * (r % 96), 32 * (r % 96), scr, F.lane); continue; } r -= I_IN;
        if (r < I_IN) { transpose_item(F.gla_w_in, INW, D, (bf16*)(F.ws + WS_WIN1), 64 * (r / 96), 32 * (r % 96), 32 * (r % 96), scr, F.lane); continue; } r -= I_IN;
        if (r < I_OUT) { transpose_item(F.fox_w_out, D, D, (bf16*)(F.ws + WS_WOUT0), 64 * (r / 32), 32 * (r % 32), 32 * (r % 32), scr, F.lane); continue; } r -= I_OUT;
        if (r < I_OUT) { transpose_item(F.gla_w_out, D, D, (bf16*)(F.ws + WS_WOUT1), 64 * (r / 32), 32 * (r % 32), 32 * (r % 32), scr, F.lane); continue; } r -= I_OUT;
        if (r < 2 * I_FI) { const int l = r / I_FI; r -= l * I_FI; const int n0 = 32 * (r % 176);
            transpose_item(F.ffn_w_in + (size_t)l * D * 2 * FFH, 2 * FFH, D, (bf16*)(F.ws + (l ? WS_FIN1 : WS_FIN0)), 64 * (r / 176), n0, ffn_in_row(n0), scr, F.lane); continue; } r -= 2 * I_FI;
        { const int l = r / I_FO; r -= l * I_FO;
            transpose_item(F.ffn_w_out + (size_t)l * FFH * D, D, FFH, (bf16*)(F.ws + (l ? WS_FOUT1 : WS_FOUT0)), 64 * (r / 32), 32 * (r % 32), 32 * (r % 32), scr, F.lane); }
    }
}

__device__ __forceinline__ float bfly32(float (&v)[32], int lane) {
#define BFLY_STEP(HALF, OFF) { const bool up = (lane & (OFF)) != 0; _Pragma("unroll") for (int i = 0; i < (HALF); ++i) { const float keep = up ? v[i + (HALF)] : v[i]; const float send = up ? v[i] : v[i + (HALF)]; v[i] = keep + __shfl_xor(send, (OFF)); } }
    BFLY_STEP(16, 32) BFLY_STEP(8, 16) BFLY_STEP(4, 8) BFLY_STEP(2, 4) BFLY_STEP(1, 2)
#undef BFLY_STEP
    return v[0] + __shfl_xor(v[0], 1);
}
__device__ __forceinline__ void norm_pass(Frame& F, const float* xin, const float* gvec, const float* modl, int shc, int mode, const float* wx) {
    LAS float* wT = (LAS float*)F.lds;
    if (mode != 2) {
        for (int e = F.tid; e < 16 * D; e += NTHR) { const int k = e >> 4, j = e & 15; wT[j * D + k] = wx[(size_t)k * INW + 3 * D + j]; }
    }
    __syncthreads();
    const int gw = F.vcu * NWAVES + F.wave, NGW = F.G * NWAVES, lane = F.lane;
    for (int r0 = gw * 16; r0 < M; r0 += NGW * 16) {
        const int b = r0 / SEQ;
        const float* mb = modl + (size_t)b * MODW;
        f32x4 wk[4], sk[4];
#pragma unroll
        for (int j = 0; j < 4; ++j) { const int k = 4 * lane + 256 * j; const f32x4 g = *(const f32x4*)(gvec + k), sc = *(const f32x4*)(mb + (shc + 1) * D + k);
            wk[j] = g * (sc + 1.0f); sk[j] = *(const f32x4*)(mb + shc * D + k); }
#pragma unroll 1
        for (int i = 0; i < 16; i += 2) {
            const int ra = r0 + i, rb = ra + 1;
            const GAS f32x4* xa = (const GAS f32x4*)(xin + (size_t)ra * D) + lane; const GAS f32x4* xb = (const GAS f32x4*)(xin + (size_t)rb * D) + lane;
            f32x4 va[4], vb[4]; float sa = 0.f, sb = 0.f;
#pragma unroll
            for (int j = 0; j < 4; ++j) { va[j] = xa[64 * j]; vb[j] = xb[64 * j]; }
#pragma unroll
            for (int j = 0; j < 4; ++j) { sa += (va[j].x * va[j].x + va[j].y * va[j].y) + (va[j].z * va[j].z + va[j].w * va[j].w); sb += (vb[j].x * vb[j].x + vb[j].y * vb[j].y) + (vb[j].z * vb[j].z + vb[j].w * vb[j].w); }
            const float ra_ = 1.0f / sqrtf(wave_sum(sa) * (1.f / D) + EPS), rb_ = 1.0f / sqrtf(wave_sum(sb) * (1.f / D) + EPS);
            GAS unsigned long long* oa = (GAS unsigned long long*)(F.XN + (size_t)ra * D) + lane; GAS unsigned long long* ob = (GAS unsigned long long*)(F.XN + (size_t)rb * D) + lane;
#pragma unroll
            for (int j = 0; j < 4; ++j) { va[j] = va[j] * ra_ * wk[j] + sk[j]; vb[j] = vb[j] * rb_ * wk[j] + sk[j];
                oa[64 * j] = (unsigned long long)pk2(va[j].x, va[j].y) | ((unsigned long long)pk2(va[j].z, va[j].w) << 32);
                ob[64 * j] = (unsigned long long)pk2(vb[j].x, vb[j].y) | ((unsigned long long)pk2(vb[j].z, vb[j].w) << 32); }
            if (mode != 2) {
                float acc[32];
#pragma unroll
                for (int hd = 0; hd < 16; ++hd) { float pa = 0.f, pb = 0.f;
#pragma unroll
                    for (int j = 0; j < 4; ++j) { const f32x4 w = *(const LAS f32x4*)(wT + hd * D + 4 * lane + 256 * j);
                        pa += (va[j].x * w.x + va[j].y * w.y) + (va[j].z * w.z + va[j].w * w.w); pb += (vb[j].x * w.x + vb[j].y * w.y) + (vb[j].z * w.z + vb[j].w * w.w); }
                    acc[hd] = pa; acc[16 + hd] = pb; if (hd & 1) asm volatile("" ::: "memory"); }
                const float tot = bfly32(acc, lane);
                const int idx = ((lane >> 5) & 1) * 16 + ((lane >> 4) & 1) * 8 + ((lane >> 3) & 1) * 4 + ((lane >> 2) & 1) * 2 + ((lane >> 1) & 1);
                if ((lane & 1) == 0) { const int row = (idx >= 16) ? rb : ra, hd = idx & 15;
                    if (mode == 0) F.LOGF[((size_t)(b * NH + hd)) * SEQ + (row - b * SEQ)] = log_sigmoid(tot + F.fox_b_f[hd]);
                    else F.ALR[(size_t)row * 16 + hd] = tot; }
            }
        }
    }
}
__device__ __forceinline__ void final_norm(Frame& F) {
    const int gw = F.vcu * NWAVES + F.wave, NGW = F.G * NWAVES, lane = F.lane;
    f32x4 g[4];
#pragma unroll
    for (int j = 0; j < 4; ++j) g[j] = *(const f32x4*)(F.final_g + 4 * lane + 256 * j);
    for (int m = gw; m < M; m += NGW) {
        GAS f32x4* xr = (GAS f32x4*)(F.out + (size_t)m * D) + lane; f32x4 v[4]; float s = 0.f;
#pragma unroll
        for (int j = 0; j < 4; ++j) { v[j] = xr[64 * j]; s += (v[j].x * v[j].x + v[j].y * v[j].y) + (v[j].z * v[j].z + v[j].w * v[j].w); }
        const float r = 1.0f / sqrtf(wave_sum(s) * (1.f / D) + EPS);
#pragma unroll
        for (int j = 0; j < 4; ++j) xr[64 * j] = v[j] * r * g[j];
    }
}
__device__ __forceinline__ void gla_onorm(Frame& F) {
    const int gw = F.vcu * NWAVES + F.wave, NGW = F.G * NWAVES, lane = F.lane;
    float go[16];
#pragma unroll
    for (int i = 0; i < 16; ++i) go[i] = F.gla_g_o[16 * lane + i];
    for (int m = gw; m < M; m += NGW) {
        const bf16* orow = F.BIG + (size_t)m * 3072 + 16 * lane;
        const v4u o0 = *(const GAS v4u*)orow, o1 = *(const GAS v4u*)(orow + 8), r0 = *(const GAS v4u*)(orow + 2048), r1 = *(const GAS v4u*)(orow + 2056);
        float ov[16], rv[16];
#pragma unroll
        for (int q = 0; q < 4; ++q) { ov[2 * q] = __uint_as_float(o0[q] << 16); ov[2 * q + 1] = __uint_as_float(o0[q] & 0xffff0000u); ov[8 + 2 * q] = __uint_as_float(o1[q] << 16); ov[8 + 2 * q + 1] = __uint_as_float(o1[q] & 0xffff0000u);
            rv[2 * q] = __uint_as_float(r0[q] << 16); rv[2 * q + 1] = __uint_as_float(r0[q] & 0xffff0000u); rv[8 + 2 * q] = __uint_as_float(r1[q] << 16); rv[8 + 2 * q + 1] = __uint_as_float(r1[q] & 0xffff0000u); }
        float ss = 0.f;
#pragma unroll
        for (int i = 0; i < 16; ++i) ss += ov[i] * ov[i];
        ss += __shfl_xor(ss, 1); ss += __shfl_xor(ss, 2); ss += __shfl_xor(ss, 4); ss += __shfl_xor(ss, 8);
        const float rs = 1.0f / sqrtf(ss * (1.f / 256.f) + EPS);
        v4u w0, w1;
#pragma unroll
        for (int q = 0; q < 4; ++q) {
            w0[q] = pk2(ov[2 * q] * rs * go[2 * q] * silu_f(rv[2 * q]), ov[2 * q + 1] * rs * go[2 * q + 1] * silu_f(rv[2 * q + 1]));
            w1[q] = pk2(ov[8 + 2 * q] * rs * go[8 + 2 * q] * silu_f(rv[8 + 2 * q]), ov[8 + 2 * q + 1] * rs * go[8 + 2 * q + 1] * silu_f(rv[8 + 2 * q + 1])); }
        bf16* xo = F.XN + (size_t)m * D + 16 * lane;
        *(GAS v4u*)xo = w0; *(GAS v4u*)(xo + 8) = w1;
    }
}

namespace pg8 {
struct EpiSwiGLU {
    static constexpr bool PERM = true, AFTER_DRAIN = false;
    bf16_t* O; int ldc;
    __device__ __forceinline__ void operator()(const f32x4 (&acc)[2][2][4][2], const Unit& u, int wr, int wc, int fr, int fq) const {
        const int row0 = u.pm * BM + wr * 64 + fr, col0 = u.pn * HALF + wc * 32 + 8 * fq;
#pragma unroll
        for (int ai = 0; ai < 2; ++ai)
#pragma unroll
            for (int m = 0; m < 4; ++m) { bf16_t* rowp = O + (size_t)(row0 + ai * HALF + m * 16) * ldc + col0;
                const f32x4 g0 = acc[ai][0][m][0], g1 = acc[ai][0][m][1], u0 = acc[ai][1][m][0], u1 = acc[ai][1][m][1];
                u32x4 w; w.x = cvt_pk_bf16(silu_f(g0[0]) * u0[0], silu_f(g0[1]) * u0[1]); w.y = cvt_pk_bf16(silu_f(g0[2]) * u0[2], silu_f(g0[3]) * u0[3]);
                w.z = cvt_pk_bf16(silu_f(g1[0]) * u1[0], silu_f(g1[1]) * u1[1]); w.w = cvt_pk_bf16(silu_f(g1[2]) * u1[2], silu_f(g1[3]) * u1[3]);
                *(u32x4*)rowp = w; }
    }
};
struct EpiResGate {
    static constexpr bool PERM = false, AFTER_DRAIN = false;
    const float* base; float* out; const float* gate;
    __device__ __forceinline__ void operator()(const f32x4 (&acc)[2][2][4][2], const Unit& u, int wr, int wc, int fr, int fq) const {
        const int row0 = u.pm * BM + wr * 64 + fr, col0 = u.pn * BM + wc * 32 + 4 * fq;
        const float* gp = gate + (size_t)((u.pm * BM) / SEQ) * MODW + col0;
        f32x4 gv[2][2];
#pragma unroll
        for (int bj = 0; bj < 2; ++bj)
#pragma unroll
            for (int n = 0; n < 2; ++n) gv[bj][n] = *(const f32x4*)(gp + bj * HALF + n * 16);
#pragma unroll
        for (int ai = 0; ai < 2; ++ai)
#pragma unroll
            for (int m = 0; m < 4; ++m) { const size_t off = (size_t)(row0 + ai * HALF + m * 16) * D + col0;
#pragma unroll
                for (int bj = 0; bj < 2; ++bj)
#pragma unroll
                    for (int n = 0; n < 2; ++n) { const f32x4 bs = *(const f32x4*)(base + off + bj * HALF + n * 16); *(f32x4*)(out + off + bj * HALF + n * 16) = bs + gv[bj][n] * acc[ai][bj][m][n]; } }
    }
};
}

constexpr int ATT_KB_OFF = 86016;
__device__ __forceinline__ void fox_attention(Frame& F, char* ldsg) {
    LAS float* kb = (LAS float*)(F.lds + ATT_KB_OFF);
    LAS float* wsum = (LAS float*)(F.lds + ATT_KB_OFF + 8192);
    const attn_body::bf16* Q = (const attn_body::bf16*)F.BIG; const attn_body::bf16* K = Q + (size_t)M * D; const attn_body::bf16* V = K + (size_t)M * D;
    for (int bh = F.vcu; bh < BATCH * NH; bh += F.G) {
        { const f32x4 v = *(const f32x4*)(F.LOGF + (size_t)bh * SEQ + 4 * F.tid);
          const float c0 = v.x, c1 = c0 + v.y, c2 = c1 + v.z, c3 = c2 + v.w;
          float inc = c3;
#pragma unroll
          for (int o = 1; o < 64; o <<= 1) { const float t = __shfl_up(inc, o); if (F.lane >= o) inc += t; }
          if (F.lane == 63) wsum[F.wave] = inc;
          __syncthreads();
          float off = 0.f;
#pragma unroll
          for (int w = 0; w < 8; ++w) { const float t = wsum[w]; if (w < F.wave) off += t; }
          const float ex = inc - c3 + off;
          *(LAS f32x4*)(kb + 4 * F.tid) = (f32x4){-(ex + c0) * LOG2E, -(ex + c1) * LOG2E, -(ex + c2) * LOG2E, -(ex + c3) * LOG2E};
          __syncthreads(); }
        const int b = bh / NH, h = bh % NH;
#pragma unroll 1
        for (int qb = SEQ / 256 - 1; qb >= 0; --qb) attn_body::attn_unit<8>(b, h, qb, Q, K, V, (attn_body::bf16*)F.BIG, ldsg, kb);
        __syncthreads();
    }
}

__device__ __forceinline__ void gla_prep(Frame& F) {
    LAS float* s_alr = (LAS float*)F.lds;
    LAS float* s_seg = (LAS float*)(F.lds + 4096);
    LAS unsigned short* s_v = (LAS unsigned short*)(F.lds + 8192);
    const int tid = F.tid;
    for (int it = F.vcu; it < BATCH * NCH * 4; it += F.G) {
        const int h = it & 3; const size_t m0 = (size_t)(it >> 2) * 64;
        if (tid < 256) ((LAS f32x4*)s_alr)[tid] = *(const f32x4*)(F.ALR + m0 * 16 + tid * 4);
        for (int p = tid; p < 2048; p += NTHR) { const int t = p >> 5, c = p & 31;
            *(LAS v4u*)(s_v + t * 264 + c * 8) = *(const GAS v4u*)(F.BIG + (m0 + t) * 3072 + 1024 + h * 256 + c * 8); }
        __syncthreads();
        const int kd = tid & 127, tq = tid >> 7;
        float w[16];
#pragma unroll
        for (int r = 0; r < 16; ++r) w[r] = F.gla_w_a2[r * 512 + h * 128 + kd];
        const float ba = F.gla_b_a[h * 128 + kd];
        float cs[16]; float run = 0.f;
#pragma unroll
        for (int tt = 0; tt < 16; ++tt) { const LAS f32x4* ap = (const LAS f32x4*)(s_alr + (16 * tq + tt) * 16); float z = ba;
#pragma unroll
            for (int q = 0; q < 4; ++q) { const f32x4 a = ap[q]; z += a.x * w[4 * q] + a.y * w[4 * q + 1] + a.z * w[4 * q + 2] + a.w * w[4 * q + 3]; }
            run += log_sigmoid(z) * (1.f / 16.f); cs[tt] = run; }
        s_seg[tq * 128 + kd] = run;
        __syncthreads();
        float off = 0.f, tot = 0.f;
#pragma unroll
        for (int q = 0; q < 4; ++q) { const float sv = s_seg[q * 128 + kd]; tot += sv; if (q < tq) off += sv; }
        const bf16* qp = F.BIG + (m0 + 16 * tq) * 3072 + h * 128 + kd; const bf16* kp = qp + 512;
        bf16* qo = F.GQI + (size_t)it * 8192 + (16 * tq) * 128 + kd; bf16* ko = F.GKI + (size_t)it * 8192 + (16 * tq) * 128 + kd;
        unsigned kdp[8];
#pragma unroll
        for (int tt = 0; tt < 16; ++tt) { const float bb = cs[tt] + off; const float q = bf2f(qp[(size_t)tt * 3072]), k = bf2f(kp[(size_t)tt * 3072]);
            qo[tt * 128] = (bf16)f2bf(q * 0.08838834764831845f * __expf(bb)); ko[tt * 128] = (bf16)f2bf(k * __expf(-bb));
            const unsigned kv = f2bf(k * __expf(tot - bb));
            if (tt & 1) kdp[tt >> 1] |= kv << 16; else kdp[tt >> 1] = kv; }
        { GAS v4u* dp = (GAS v4u*)(F.GKDT + (size_t)it * 8192 + kd * 64 + 16 * tq); dp[0] = (v4u){kdp[0], kdp[1], kdp[2], kdp[3]}; dp[1] = (v4u){kdp[4], kdp[5], kdp[6], kdp[7]}; }
        if (tq == 0) F.DEC[(size_t)it * 128 + kd] = __expf(tot);
        { const int vc = tid & 255, hf = tid >> 8; unsigned pk[16];
#pragma unroll
          for (int q = 0; q < 16; ++q) { const int t = 32 * hf + 2 * q; pk[q] = (unsigned)s_v[t * 264 + vc] | ((unsigned)s_v[(t + 1) * 264 + vc] << 16); }
          GAS v4u* dp = (GAS v4u*)(F.GVT + (size_t)it * 16384 + vc * 64 + 32 * hf);
#pragma unroll
          for (int q = 0; q < 4; ++q) dp[q] = (v4u){pk[4 * q], pk[4 * q + 1], pk[4 * q + 2], pk[4 * q + 3]}; }
        __syncthreads();
    }
}

__device__ __forceinline__ void gla_scan(Frame& F) {
    constexpr int P128 = 272, P64 = 144;
    constexpr int O_QI = 0, O_KI = O_QI + 64 * P128, O_KDT = O_KI + 64 * P128, O_VT = O_KDT + 128 * P64, O_A = O_VT + 64 * P64, O_ST0 = O_A + 64 * P64, O_ST1 = O_ST0 + 64 * P128, O_DEC = O_ST1 + 64 * P128;
    static_assert(O_DEC + 512 <= RING_BYTES, "gla_scan LDS");
    LAS unsigned char* lds = F.lds;
    const int tid = F.tid, lane = F.lane, w = F.wave, fr = lane & 15, fq = lane >> 4;
    typedef unsigned u32x2 __attribute__((ext_vector_type(2)));
#define MFMA16(a, b, c) __builtin_amdgcn_mfma_f32_16x16x32_bf16((a), (b), (c), 0, 0, 0)
    for (int u = F.vcu; u < 256; u += F.G) {
        const int bh = u >> 2, vs = u & 3, b = bh >> 2, h = bh & 3;
        for (int p = tid; p < (64 * P128) / 16; p += NTHR) *(LAS v4u*)(lds + O_ST0 + p * 16) = (v4u){0u, 0u, 0u, 0u};
        f32x4 S[4];
#pragma unroll
        for (int j = 0; j < 4; ++j) S[j] = (f32x4){0.f, 0.f, 0.f, 0.f};
        v4u rq[2], rk[2], rd[2], rv; float rdec = 0.f;
#define GS_LOAD(n) do { const size_t it_ = (size_t)((b * NCH + (n)) * 4 + h); \
        const GAS v4u* q_ = (const GAS v4u*)(F.GQI + it_ * 8192); const GAS v4u* k_ = (const GAS v4u*)(F.GKI + it_ * 8192); const GAS v4u* d_ = (const GAS v4u*)(F.GKDT + it_ * 8192); \
        rq[0] = q_[tid]; rq[1] = q_[tid + 512]; rk[0] = k_[tid]; rk[1] = k_[tid + 512]; rd[0] = d_[tid]; rd[1] = d_[tid + 512]; \
        rv = ((const GAS v4u*)(F.GVT + it_ * 16384 + vs * 4096))[tid]; if (tid < 128) rdec = F.DEC[it_ * 128 + tid]; } while (0)
        GS_LOAD(0);
#pragma unroll 1
        for (int n = 0; n < NCH; ++n) {
            __syncthreads();
#pragma unroll
            for (int i = 0; i < 2; ++i) { const int p = tid + 512 * i;
                *(LAS v4u*)(lds + O_QI + (p >> 4) * P128 + (p & 15) * 16) = rq[i]; *(LAS v4u*)(lds + O_KI + (p >> 4) * P128 + (p & 15) * 16) = rk[i];
                *(LAS v4u*)(lds + O_KDT + (p >> 3) * P64 + (p & 7) * 16) = rd[i]; }
            *(LAS v4u*)(lds + O_VT + (tid >> 3) * P64 + (tid & 7) * 16) = rv;
            if (tid < 128) ((LAS float*)(lds + O_DEC))[tid] = rdec;
            if (n + 1 < NCH) GS_LOAD(n + 1);
            __syncthreads();
            const int tb = w & 3, g2 = 2 * (w >> 2);
            bf16x8 qf[4];
#pragma unroll
            for (int kk = 0; kk < 4; ++kk) qf[kk] = *(const LAS bf16x8*)(lds + O_QI + (16 * tb + fr) * P128 + fq * 16 + kk * 64);
#pragma unroll
            for (int j = 0; j < 2; ++j) { const int sb = g2 + j; f32x4 a = (f32x4){0.f, 0.f, 0.f, 0.f};
#pragma unroll
                for (int kk = 0; kk < 4; ++kk) { const bf16x8 kf = *(const LAS bf16x8*)(lds + O_KI + (16 * sb + fr) * P128 + fq * 16 + kk * 64); a = MFMA16(kf, qf[kk], a); }
                const int t = 16 * tb + fr, s0 = 16 * sb + 4 * fq;
                u32x2 pkd; pkd.x = pk2(s0 + 0 <= t ? a[0] : 0.f, s0 + 1 <= t ? a[1] : 0.f); pkd.y = pk2(s0 + 2 <= t ? a[2] : 0.f, s0 + 3 <= t ? a[3] : 0.f);
                *(LAS u32x2*)(lds + O_A + t * P64 + s0 * 2) = pkd; }
            { const f32x4 dv = *(const LAS f32x4*)(lds + O_DEC + (16 * w + 4 * fq) * 4);
              bf16x8 af[2];
#pragma unroll
              for (int kk = 0; kk < 2; ++kk) af[kk] = *(const LAS bf16x8*)(lds + O_KDT + (16 * w + fr) * P64 + fq * 16 + kk * 64);
              const int stn = ((n + 1) & 1) ? O_ST1 : O_ST0;
#pragma unroll
              for (int j = 0; j < 4; ++j) { S[j] = S[j] * dv;
#pragma unroll
                  for (int kk = 0; kk < 2; ++kk) { const bf16x8 vf = *(const LAS bf16x8*)(lds + O_VT + (16 * j + fr) * P64 + fq * 16 + kk * 64); S[j] = MFMA16(af[kk], vf, S[j]); }
                  u32x2 pkd; pkd.x = pk2(S[j][0], S[j][1]); pkd.y = pk2(S[j][2], S[j][3]);
                  *(LAS u32x2*)(lds + stn + (16 * j + fr) * P128 + (16 * w + 4 * fq) * 2) = pkd; } }
            __syncthreads();
            { const int stc = (n & 1) ? O_ST1 : O_ST0;
              bf16x8 a2[2];
#pragma unroll
              for (int kk = 0; kk < 2; ++kk) a2[kk] = *(const LAS bf16x8*)(lds + O_A + (16 * tb + fr) * P64 + fq * 16 + kk * 64);
              const size_t mrow = (size_t)b * SEQ + n * 64 + 16 * tb + fr;
#pragma unroll
              for (int j = 0; j < 2; ++j) { const int vcb = g2 + j; f32x4 o = (f32x4){0.f, 0.f, 0.f, 0.f};
#pragma unroll
                  for (int kk = 0; kk < 2; ++kk) { const bf16x8 vf = *(const LAS bf16x8*)(lds + O_VT + (16 * vcb + fr) * P64 + fq * 16 + kk * 64); o = MFMA16(vf, a2[kk], o); }
#pragma unroll
                  for (int kk = 0; kk < 4; ++kk) { const bf16x8 sf = *(const LAS bf16x8*)(lds + stc + (16 * vcb + fr) * P128 + fq * 16 + kk * 64); o = MFMA16(sf, qf[kk], o); }
                  u32x2 pkd; pkd.x = pk2(o[0], o[1]); pkd.y = pk2(o[2], o[3]);
                  *(GAS u32x2*)(F.BIG + mrow * 3072 + h * 256 + vs * 64 + 16 * vcb + 4 * fq) = pkd; } }
        }
        __syncthreads();
    }
#undef GS_LOAD
#undef MFMA16
}

__global__ void __launch_bounds__(NTHR, 2) fwd_megakernel(Args args) {
    extern __shared__ __attribute__((aligned(16))) unsigned char lds[];
    Frame F;
    F.lds = (LAS unsigned char*)lds;
    F.tid = threadIdx.x; F.lane = F.tid & 63; F.wave = __builtin_amdgcn_readfirstlane(F.tid >> 6);
    F.G = gridDim.x; { const int bx = blockIdx.x; F.vcu = (F.G % 8 == 0) ? (bx % 8) * (F.G / 8) + bx / 8 : bx; }
    F.x = args.in[0]; F.c = args.in[1]; F.ada_w = args.in[2]; F.ada_b = args.in[3]; F.norm1_g = args.in[4]; F.norm2_g = args.in[5]; F.ffn_w_in = args.in[6]; F.ffn_w_out = args.in[7];
    F.fox_w_in = args.in[8]; F.fox_b_f = args.in[9]; F.fox_w_out = args.in[10]; F.gla_w_in = args.in[11]; F.gla_w_a2 = args.in[12]; F.gla_b_a = args.in[13]; F.gla_g_o = args.in[14]; F.gla_w_out = args.in[15]; F.final_g = args.in[16];
    F.out = args.out; F.ws = args.ws;
    unsigned char* ws = args.ws;
    F.MOD = (float*)(ws + WS_MOD); F.LOGF = (float*)(ws + WS_LOGF); F.ALR = (float*)(ws + WS_ALR); F.DEC = (float*)(ws + WS_DEC);
    F.XN = (bf16*)(ws + WS_XN); F.BIG = (bf16*)(ws + WS_BIG); F.GQI = (bf16*)(ws + WS_GQI); F.GKI = (bf16*)(ws + WS_GKI); F.GKDT = (bf16*)(ws + WS_GKDT); F.GVT = (bf16*)(ws + WS_GVT);
    const int lo = args.ph_lo, hi = args.ph_hi;
    bool first = true;
    if (F.tid < 64) ((LAS unsigned*)(F.lds + RING_BYTES))[F.tid + 64] = 0u;
    __syncthreads();
#if MK_MULTI
#define GRID_BAR() ((void)0)
#else
    XcdBarrier bar = xcd_barrier_post((unsigned*)(ws + WS_CTL) + CW_BAR, (volatile LAS unsigned*)(F.lds + MISC_OFF) + 8);
    bool cgdone = false;
#define GRID_BAR() (cgdone ? xcd_barrier(bar) : (cg::this_grid().sync(), (void)(cgdone = true)))
#endif
#define PHASE(id) if (lo <= (id) && (id) < hi && ((first ? (void)0 : (void)(GRID_BAR())), first = false, frame_tid(F), true))

    PHASE(0) { p0_prologue(F); }
#pragma unroll 1
    for (int l = 0; l < 2; ++l) {
        const int pb = 1 + 9 * l;
        const float* modl = F.MOD + (size_t)l * 16 * MODW;
        const float* xcur = l == 0 ? F.x : F.out;
        PHASE(pb + 0) { norm_pass(F, xcur, F.norm1_g + l * D, modl, 0, l, l == 0 ? F.fox_w_in : F.gla_w_in); }
        PHASE(pb + 1) {
            pg8::Gemm g{F.XN, (const bf16*)(ws + (l ? WS_WIN1 : WS_WIN0)), M, 3 * D, D}; pg8::StaticOrder S; S.init(M, 3 * D, F.G, (int)blockIdx.x);
            pg8::EpiBf16<0> E{F.BIG, l == 0 ? D : 3 * D, nullptr, l == 0 ? D : 0, (size_t)M * D, attn_body::C2};
            pg8::gemm_phase<pg8::EpiBf16<0>, pg8::StaticOrder, PG8_ALIGN, PG8_SP2>(F.lds, g, S, E);
        }
        if (l == 0) {
            PHASE(pb + 2) { fox_attention(F, (char*)lds); }
        } else {
            PHASE(pb + 2) { gla_prep(F); }
            PHASE(pb + 3) { gla_scan(F); }
            PHASE(pb + 4) { gla_onorm(F); }
        }
        PHASE(pb + 5) {
            pg8::Gemm g{l == 0 ? F.BIG : F.XN, (const bf16*)(ws + (l ? WS_WOUT1 : WS_WOUT0)), M, D, D}; pg8::StaticOrder S; S.init(M, D, F.G, (int)blockIdx.x);
            pg8::EpiResGate E{xcur, F.out, modl + 2 * D};
            pg8::gemm_phase<pg8::EpiResGate, pg8::StaticOrder, PG8_ALIGN, PG8_SP2>(F.lds, g, S, E);
        }
        PHASE(pb + 6) { norm_pass(F, F.out, F.norm2_g + l * D, modl, 3, 2, nullptr); }
        PHASE(pb + 7) {
            pg8::Gemm g{F.XN, (const bf16*)(ws + (l ? WS_FIN1 : WS_FIN0)), M, 2 * FFH, D}; pg8::StaticOrder S; S.init(M, 2 * FFH, F.G, (int)blockIdx.x);
            pg8::EpiSwiGLU E{F.BIG, FFH};
            pg8::gemm_phase<pg8::EpiSwiGLU, pg8::StaticOrder, PG8_ALIGN, PG8_SP2>(F.lds, g, S, E);
        }
        PHASE(pb + 8) {
            pg8::Gemm g{F.BIG, (const bf16*)(ws + (l ? WS_FOUT1 : WS_FOUT0)), M, D, FFH}; pg8::StaticOrder S; S.init(M, D, F.G, (int)blockIdx.x);
            pg8::EpiResGate E{F.out, F.out, modl + 5 * D};
            pg8::gemm_phase<pg8::EpiResGate, pg8::StaticOrder, PG8_ALIGN, PG8_SP2>(F.lds, g, S, E);
        }
    }
    PHASE(19) { final_norm(F); }
#undef PHASE
}

constexpr int N_PHASES = 20;
extern "C" void kernel_launch(void* const* d_in, const int* in_sizes, int n_in, void* d_out, int out_size, void* d_ws, size_t ws_size, hipStream_t stream) {
    static int grid = 0;
    if (grid == 0) {
        if (n_in != 17 || in_sizes[0] != M * D || out_size != M * D || ws_size < WS_END) { fprintf(stderr, "kernel_launch: unexpected problem: n_in %d in0 %d out %d ws %zu (need %zu)\n", n_in, n_in > 0 ? in_sizes[0] : -1, out_size, ws_size, (size_t)WS_END); grid = -1; return; }
        int dev = 0, cus = 0, per_cu = 0;
        if (hipGetDevice(&dev) != hipSuccess || hipDeviceGetAttribute(&cus, hipDeviceAttributeMultiprocessorCount, dev) != hipSuccess) { grid = -1; return; }
        if (hipFuncSetAttribute((const void*)fwd_megakernel, hipFuncAttributeMaxDynamicSharedMemorySize, LDS_BYTES) != hipSuccess) { fprintf(stderr, "kernel_launch: hipFuncSetAttribute failed\n"); grid = -1; return; }
        if (hipOccupancyMaxActiveBlocksPerMultiprocessor(&per_cu, (const void*)fwd_megakernel, NTHR, LDS_BYTES) != hipSuccess || per_cu < 1) { fprintf(stderr, "kernel_launch: occupancy query says %d blocks/CU\n", per_cu); per_cu = 1; }
        (void)hipGetLastError();
        grid = cus * 1;
    }
    if (grid < 0) return;
    if (hipMemsetAsync((char*)d_ws + WS_CTL, 0, 65536, stream) != hipSuccess) { fprintf(stderr, "kernel_launch: memset of the barrier words failed\n"); return; }
    Args a{};
    for (int i = 0; i < 17; ++i) a.in[i] = (const float*)d_in[i];
    a.out = (float*)d_out; a.ws = (unsigned char*)d_ws;
#if MK_MULTI
    for (int p = 0; p < N_PHASES; ++p) { if (p == 4 || p == 5) continue; a.ph_lo = p; a.ph_hi = p + 1; hipLaunchKernelGGL(fwd_megakernel, dim3(grid), dim3(NTHR), LDS_BYTES, stream, a); }
#else
    a.ph_lo = 0; a.ph_hi = N_PHASES;
    void* kargs[] = {&a};
    const hipError_t e = hipLaunchCooperativeKernel((const void*)fwd_megakernel, dim3(grid), dim3(NTHR), kargs, LDS_BYTES, stream);
    if (e != hipSuccess) fprintf(stderr, "kernel_launch: cooperative launch failed: %s (grid %d)\n", hipGetErrorString(e), grid);
#endif
}
```

```cpp
#include <hip/hip_runtime.h>
#include <cstdio>
#include <cstdint>
namespace pg8 {
#define PG8_LAS __attribute__((address_space(3)))
typedef unsigned short bf16_t;
typedef short bf16x8 __attribute__((ext_vector_type(8)));
typedef float f32x4 __attribute__((ext_vector_type(4)));
typedef unsigned u32x4 __attribute__((ext_vector_type(4)));
constexpr int BM = 256, BK = 64, HALF = 128, HTB = HALF * BK * 2  , STAGE_BYTES = 8 * HTB, NXCD = 8, WGM = 8;

__host__ __device__ __forceinline__ int lds_byte(int r, int c) { const int st = (r >> 4) * 2 + (c >> 5), rr = r & 15, cc = c & 31, ob = rr * 64 + cc * 2; return st * 1024 + (ob ^ (((ob >> 9) & 1) << 5)); }
__host__ __device__ __forceinline__ void stage_rc(int b, int& R, int& C) { const int st = b / 1024, sb = b % 1024, swz = sb ^ (((sb >> 9) & 1) << 5); R = (st >> 1) * 16 + swz / 64; C = (st & 1) * 32 + (swz % 64) / 2; }
__host__ __device__ __forceinline__ int perm32(int rho) { const int n = rho >> 4, i = rho & 15; return 8 * (i >> 2) + 4 * n + (i & 3); }

struct Unit { int pm, pn; };
struct Gemm { const bf16_t* A; const bf16_t* Bt; int M, N, K; };

struct StaticOrder {
    int nM, nN, nwg, G, c;
    __host__ __device__ void init(int M, int N, int G_, int c_) { nM = M / BM; nN = N / BM; nwg = nM * nN; G = G_; c = c_; }
    __host__ __device__ bool next(int i, Unit& u) const {
        const long L = (long)i * G + c; if (L >= nwg) return false;
        int wgid = (int)L; { const int q = nwg / NXCD, r = nwg % NXCD, xcd = wgid % NXCD, off = wgid / NXCD; wgid = (xcd < r ? xcd * (q + 1) : r * (q + 1) + (xcd - r) * q) + off; }
        const int nig = WGM * nN, gid = wgid / nig, fm = gid * WGM, gsz = (nM - fm) < WGM ? (nM - fm) : WGM;
        u.pm = fm + ((wgid % nig) % gsz); u.pn = (wgid % nig) / gsz; return true;
    }
    __device__ __forceinline__ void a_ready(const Unit&) const {}
    __device__ __forceinline__ void done(const Unit&) const {}
};

__device__ __forceinline__ unsigned cvt_pk_bf16(float lo, float hi) { unsigned r; asm volatile("v_cvt_pk_bf16_f32 %0, %1, %2" : "=v"(r) : "v"(lo), "v"(hi)); return r; }
typedef float f32x2 __attribute__((ext_vector_type(2)));
__device__ __forceinline__ f32x2 gelu_pk(f32x2 v) {
    const f32x2 av = __builtin_elementwise_abs(v), d = av * 0.2316418882f + 1.0f;
    f32x2 t; t.x = __builtin_amdgcn_rcpf(d.x); t.y = __builtin_amdgcn_rcpf(d.y);
    f32x2 q = t * 0.5307027145f + (-0.7265760135f); q = q * t + 0.7107068705f; q = q * t + (-0.142248368f); q = q * t + 0.127414796f; q = q * t;
    const f32x2 s = (v * v) * (-0.72134752044f);
    f32x2 e; e.x = __builtin_amdgcn_exp2f(s.x); e.y = __builtin_amdgcn_exp2f(s.y);
    const f32x2 m = v * (q * e), r = v - m;
    f32x2 o; o.x = v.x < 0.f ? m.x : r.x; o.y = v.y < 0.f ? m.y : r.y; return o;
}

template <int ACT  > struct EpiBf16 {
    static constexpr bool PERM = true, AFTER_DRAIN = false; static_assert(ACT == 0 || ACT == 1, "EpiBf16: ACT is 0 (none) or 1 (gelu_pk)");
    bf16_t* O; int ldc; const float* bias; int split_cols; size_t split_stride; float scale0;
    __device__ __forceinline__ void operator()(const f32x4 (&acc)[2][2][4][2], const Unit& u, int wr, int wc, int fr, int fq) const {
        const int row0 = u.pm * BM + wr * 64 + fr; int colt = u.pn * BM; bf16_t* base = O;
        float sc = 1.f; if (split_cols) { const int t = colt / split_cols; base += (size_t)t * split_stride; colt -= t * split_cols; if (t == 0) sc = scale0; }
        const int col0 = colt + wc * 32 + 8 * fq, bcol0 = u.pn * BM + wc * 32 + 8 * fq;
        f32x4 bv[2][2];
#pragma unroll
        for (int bj = 0; bj < 2; ++bj)
#pragma unroll
            for (int n = 0; n < 2; ++n) bv[bj][n] = bias ? *(const f32x4*)(bias + bcol0 + bj * HALF + 4 * n) : (f32x4){0.f, 0.f, 0.f, 0.f};
#pragma unroll
        for (int ai = 0; ai < 2; ++ai)
#pragma unroll
            for (int m = 0; m < 4; ++m) { bf16_t* rowp = base + (size_t)(row0 + ai * HALF + m * 16) * ldc + col0;
#pragma unroll
                for (int bj = 0; bj < 2; ++bj) { f32x4 v0 = acc[ai][bj][m][0] + bv[bj][0], v1 = acc[ai][bj][m][1] + bv[bj][1];
                    if (ACT == 1) { f32x2 a = gelu_pk((f32x2){v0[0], v0[1]}), b = gelu_pk((f32x2){v0[2], v0[3]}), c = gelu_pk((f32x2){v1[0], v1[1]}), d = gelu_pk((f32x2){v1[2], v1[3]});
                        v0 = (f32x4){a.x, a.y, b.x, b.y}; v1 = (f32x4){c.x, c.y, d.x, d.y}; }
                    v0 = v0 * sc; v1 = v1 * sc; u32x4 w; w.x = cvt_pk_bf16(v0[0], v0[1]); w.y = cvt_pk_bf16(v0[2], v0[3]); w.z = cvt_pk_bf16(v1[0], v1[1]); w.w = cvt_pk_bf16(v1[2], v1[3]);
                    *(u32x4*)(rowp + bj * HALF) = w; } }
    }
};

template <class Epi, class Sched, bool ALIGN_EPI = false, bool SP2 = false>
__device__ __forceinline__ void gemm_phase(PG8_LAS unsigned char* lds, const Gemm g, const Sched& S, const Epi& E) {
    int tid_ = threadIdx.x; asm volatile("" : "+v"(tid_));
    const int tid = tid_, wid = __builtin_amdgcn_readfirstlane(tid >> 6), lane = tid & 63, wr = wid >> 2, wc = wid & 3, fr = lane & 15, fq = lane >> 4;
    const int K = g.K, nt = K / BK;
    unsigned voffA[2], voffB[2];
#pragma unroll
    for (int i = 0; i < 2; ++i) { int R, C; stage_rc(tid * 16 + i * 8192, R, C); const int Rb = Epi::PERM ? ((R & ~31) + perm32(R & 31)) : R;
        voffA[i] = (unsigned)(R * K + C) * 2u; voffB[i] = (unsigned)(Rb * K + C) * 2u; }
    const size_t kstep = (size_t)(BK * 2);
    const size_t hstep = (size_t)HALF * K * 2;
    const size_t tstep = 2 * hstep;
    const unsigned ldsw = (unsigned)wid * 1024u;
    const int aoff = lds_byte(wr * 64 + fr, fq * 8), boff = lds_byte(wc * 32 + fr, fq * 8);
#define PG8_SA(b, h) (((b) * 2 + (h)) * HTB)
#define PG8_SB(b, h) ((4 + (b) * 2 + (h)) * HTB)
#define PG8_STAGE(bufoff, gbase, voff) do { _Pragma("unroll") for (int _i = 0; _i < 2; ++_i) \
        __builtin_amdgcn_global_load_lds((const unsigned*)((const char*)(gbase) + (voff)[_i]), (PG8_LAS unsigned*)(lds + (bufoff) + ldsw + _i * 8192), 16, 0, 0); } while (0)
#define PG8_LDA(dst, b, h) do { _Pragma("unroll") for (int m = 0; m < 4; ++m) _Pragma("unroll") for (int k = 0; k < 2; ++k) dst[m][k] = *(const PG8_LAS bf16x8*)(lds + PG8_SA(b, h) + aoff + m * 2048 + k * 1024); } while (0)
#define PG8_LDB(dst, b, h) do { _Pragma("unroll") for (int n = 0; n < 2; ++n) _Pragma("unroll") for (int k = 0; k < 2; ++k) dst[n][k] = *(const PG8_LAS bf16x8*)(lds + PG8_SB(b, h) + boff + n * 2048 + k * 1024); } while (0)
#define PG8_MMA(ai, bj, At, Bt) do { __builtin_amdgcn_s_setprio(1); _Pragma("unroll") for (int m = 0; m < 4; ++m) _Pragma("unroll") for (int n = 0; n < 2; ++n) _Pragma("unroll") for (int k = 0; k < 2; ++k) \
        acc[ai][bj][m][n] = __builtin_amdgcn_mfma_f32_16x16x32_bf16(Bt[n][k], At[m][k], acc[ai][bj][m][n], 0, 0, 0); __builtin_amdgcn_s_setprio(0); } while (0)
#define PG8_WAIT_V(n) asm volatile("s_waitcnt vmcnt(" #n ")" ::: "memory")
#define PG8_WAIT_L(n) asm volatile("s_waitcnt lgkmcnt(" #n ")" ::: "memory")
#define PG8_BAR __builtin_amdgcn_s_barrier()
#define PG8_SCHED __builtin_amdgcn_sched_barrier(0)
    Unit cur, nxt; int ui = 0;
    if (!S.next(0, cur)) return;
    f32x4 acc[2][2][4][2];
#pragma unroll
    for (int a = 0; a < 2; ++a)
#pragma unroll
        for (int b = 0; b < 2; ++b)
#pragma unroll
            for (int m = 0; m < 4; ++m)
#pragma unroll
                for (int n = 0; n < 2; ++n) acc[a][b][m][n] = (f32x4){0.f, 0.f, 0.f, 0.f};
    bf16x8 At[4][2], B0[2][2], B1[2][2];
    const char* cA = (const char*)g.A + (size_t)cur.pm * tstep; const char* cB = (const char*)g.Bt + (size_t)cur.pn * tstep;
    S.a_ready(cur);
    if constexpr (SP2) {
        PG8_STAGE(PG8_SB(0, 0), cB, voffB); PG8_STAGE(PG8_SB(0, 1), cB + hstep, voffB); PG8_STAGE(PG8_SA(0, 0), cA, voffA); PG8_STAGE(PG8_SA(0, 1), cA + hstep, voffA);
        if (wr == 1) PG8_BAR;
        PG8_WAIT_V(2); PG8_BAR;
        PG8_STAGE(PG8_SB(1, 0), cB + kstep, voffB); PG8_STAGE(PG8_SA(1, 0), cA + kstep, voffA); PG8_STAGE(PG8_SB(1, 1), cB + hstep + kstep, voffB);
        PG8_WAIT_V(6); PG8_BAR;
    } else {
        PG8_STAGE(PG8_SB(0, 0), cB, voffB); PG8_STAGE(PG8_SA(0, 0), cA, voffA); PG8_STAGE(PG8_SB(0, 1), cB + hstep, voffB); PG8_STAGE(PG8_SA(0, 1), cA + hstep, voffA);
        if (wr == 1) PG8_BAR;
        PG8_WAIT_V(4); PG8_BAR;
        PG8_STAGE(PG8_SB(1, 0), cB + kstep, voffB); PG8_STAGE(PG8_SA(1, 0), cA + kstep, voffA); PG8_STAGE(PG8_SB(1, 1), cB + hstep + kstep, voffB);
        PG8_WAIT_V(6); PG8_BAR;
    }
    for (;;) {
        const bool has_next = S.next(ui + 1, nxt);
        const char* nA = has_next ? (const char*)g.A + (size_t)nxt.pm * tstep : cA; const char* nB = has_next ? (const char*)g.Bt + (size_t)nxt.pn * tstep : cB;
        for (int t = 0; t < nt; t += 2) {
            const bool last = (t == nt - 2);
            const char* a1 = cA + (size_t)(t + 1) * kstep;
            const char* a2 = last ? nA : cA + (size_t)(t + 2) * kstep; const char* b2 = last ? nB : cB + (size_t)(t + 2) * kstep;
            const char* a3 = a2 + kstep; const char* b3 = b2 + kstep;
            if (last && has_next) S.a_ready(nxt);
            if constexpr (SP2) {
            PG8_LDB(B0, 0, 0); PG8_LDB(B1, 0, 1); PG8_SCHED; PG8_LDA(At, 0, 0); PG8_STAGE(PG8_SA(1, 1), a1 + hstep, voffA);
            PG8_WAIT_V(8); PG8_WAIT_L(0); PG8_BAR; PG8_MMA(0, 0, At, B0); PG8_MMA(0, 1, At, B1); PG8_BAR; PG8_SCHED;
            PG8_LDA(At, 0, 1); PG8_STAGE(PG8_SB(0, 0), b2, voffB); PG8_STAGE(PG8_SB(0, 1), b2 + hstep, voffB); PG8_STAGE(PG8_SA(0, 0), a2, voffA);
            PG8_WAIT_V(8); PG8_WAIT_L(0); PG8_BAR; PG8_MMA(1, 0, At, B0); PG8_MMA(1, 1, At, B1); PG8_BAR; PG8_SCHED;
            PG8_LDB(B0, 1, 0); PG8_LDB(B1, 1, 1); PG8_SCHED; PG8_LDA(At, 1, 0); PG8_STAGE(PG8_SA(0, 1), a2 + hstep, voffA);
            PG8_WAIT_V(8); PG8_WAIT_L(0); PG8_BAR; PG8_MMA(0, 0, At, B0); PG8_MMA(0, 1, At, B1); PG8_BAR; PG8_SCHED;
            PG8_LDA(At, 1, 1); PG8_STAGE(PG8_SB(1, 0), b3, voffB); PG8_STAGE(PG8_SB(1, 1), b3 + hstep, voffB); PG8_STAGE(PG8_SA(1, 0), a3, voffA);
            PG8_WAIT_V(8); PG8_WAIT_L(0); PG8_BAR; PG8_MMA(1, 0, At, B0); PG8_MMA(1, 1, At, B1); PG8_BAR; PG8_SCHED;
            } else {
            PG8_LDB(B0, 0, 0); PG8_SCHED; PG8_LDA(At, 0, 0); PG8_STAGE(PG8_SA(1, 1), a1 + hstep, voffA);
            PG8_WAIT_L(8); PG8_BAR; PG8_WAIT_L(0); PG8_MMA(0, 0, At, B0); PG8_BAR; PG8_SCHED;
            PG8_LDB(B1, 0, 1); PG8_STAGE(PG8_SB(0, 0), b2, voffB);
            PG8_BAR; PG8_WAIT_L(0); PG8_MMA(0, 1, At, B1); PG8_BAR;
            PG8_LDA(At, 0, 1); PG8_STAGE(PG8_SA(0, 0), a2, voffA);
            PG8_BAR; PG8_WAIT_L(0); PG8_MMA(1, 0, At, B0); PG8_BAR; PG8_SCHED;
            PG8_STAGE(PG8_SB(0, 1), b2 + hstep, voffB);
            PG8_WAIT_V(6); PG8_BAR; PG8_MMA(1, 1, At, B1); PG8_BAR;
            PG8_LDB(B0, 1, 0); PG8_SCHED; PG8_LDA(At, 1, 0); PG8_STAGE(PG8_SA(0, 1), a2 + hstep, voffA);
            PG8_WAIT_L(8); PG8_BAR; PG8_WAIT_L(0); PG8_MMA(0, 0, At, B0); PG8_BAR; PG8_SCHED;
            PG8_LDB(B1, 1, 1); PG8_STAGE(PG8_SB(1, 0), b3, voffB);
            PG8_BAR; PG8_WAIT_L(0); PG8_MMA(0, 1, At, B1); PG8_BAR;
            PG8_LDA(At, 1, 1); PG8_STAGE(PG8_SA(1, 0), a3, voffA);
            PG8_BAR; PG8_WAIT_L(0); PG8_MMA(1, 0, At, B0); PG8_BAR; PG8_SCHED;
            PG8_STAGE(PG8_SB(1, 1), b3 + hstep, voffB);
            PG8_WAIT_V(6); PG8_BAR; PG8_MMA(1, 1, At, B1); PG8_BAR;
            }
        }
        if constexpr (ALIGN_EPI) { if (wr == 0) PG8_BAR; }
        if constexpr (!Epi::AFTER_DRAIN) { E(acc, cur, wr, wc, fr, fq); S.done(cur); }
        if (!has_next) break;
#pragma unroll
        for (int a = 0; a < 2; ++a)
#pragma unroll
            for (int b = 0; b < 2; ++b)
#pragma unroll
                for (int m = 0; m < 4; ++m)
#pragma unroll
                    for (int n = 0; n < 2; ++n) acc[a][b][m][n] = (f32x4){0.f, 0.f, 0.f, 0.f};
        cur = nxt; cA = nA; cB = nB; ++ui;
        if constexpr (ALIGN_EPI) { if (wr == 1) PG8_BAR; }
    }
    PG8_WAIT_V(0);
    if constexpr (!ALIGN_EPI) { if (wr == 0) PG8_BAR; }
    PG8_BAR;
    if constexpr (Epi::AFTER_DRAIN) { E.fused(acc, cur, wr, wc, fr, fq, lds, wid, lane); S.done(cur); }
#undef PG8_SA
#undef PG8_SB
#undef PG8_STAGE
#undef PG8_LDA
#undef PG8_LDB
#undef PG8_MMA
#undef PG8_WAIT_V
#undef PG8_WAIT_L
#undef PG8_BAR
#undef PG8_SCHED
}
}

#ifndef PG8_SP2
#define PG8_SP2 true
#endif
#ifndef PG8_ALIGN
#define PG8_ALIGN true
#endif
#include <hip/hip_bf16.h>
#include <cmath>
namespace attn_body {
using bf16=__hip_bfloat16;
using bf16x8=__attribute__((ext_vector_type(8)))short;
using s16x4=__attribute__((ext_vector_type(4)))short;
using f32x16=__attribute__((ext_vector_type(16)))float;
using u32x4=__attribute__((ext_vector_type(4)))unsigned;
constexpr int BATCH=16,NHEAD=16,SEQ=2048,D=64,DM=NHEAD*D;
constexpr int NW=8,QBLK=32,QB=QBLK*NW,KVBLK=64,NQB=SEQ/QB;
constexpr int ATTN_PITCH=DM, ATTN_UNIT_ROWS=QB;
__device__ __forceinline__ int crow(int r,int hi){return (r&3)+8*(r>>2)+4*hi;}
#define SBAR() __builtin_amdgcn_sched_barrier(0)
__device__ __forceinline__ void cmask(f32x16&p0,f32x16&p1,int jb,int qrel,int hi){
  const float NEG=-INFINITY; int kb=64*jb+4*hi;
  #pragma unroll
  for(int r=0;r<16;++r){int kv=kb+(r&3)+8*(r>>2); if(kv>qrel)p0[r]=NEG; if(kv+32>qrel)p1[r]=NEG;}
}

constexpr int NSLOT=3, SLOTB=8192;
constexpr int LDS_K=0, LDS_V=NSLOT*SLOTB, LDS_WS=2*NSLOT*SLOTB, LDS_OST=LDS_WS+NW*64*4, LDS_BYTES=LDS_OST+NW*4096;
constexpr float C2=0.125f*1.4426950408889634f;
__device__ __forceinline__ void glds16(const void*gsrc,unsigned lds_dst){unsigned keep;
  asm volatile("s_mov_b32 %0, m0\n\ts_mov_b32 m0, %2\n\ts_nop 0\n\tglobal_load_lds_dwordx4 %1, off\n\ts_mov_b32 m0, %0":"=&s"(keep):"v"(gsrc),"s"(lds_dst):"memory");}
__device__ __forceinline__ float max3f(float a,float b,float c){float r;asm("v_max3_f32 %0, %1, %2, %3":"=v"(r):"v"(a),"v"(b),"v"(c));return r;}
__device__ __forceinline__ float max2f(float a,float b){float r;asm("v_max_f32_e32 %0, %1, %2":"=v"(r):"v"(a),"v"(b));return r;}
__device__ __forceinline__ float fadd_s(float a,float b){float r;asm("v_add_f32_e32 %0, %1, %2":"=v"(r):"v"(a),"v"(b));return r;}
__device__ __forceinline__ float fsub_s(float a,float b){float r;asm("v_sub_f32_e32 %0, %1, %2":"=v"(r):"v"(a),"v"(b));return r;}
typedef float f32x2_t __attribute__((ext_vector_type(2))); typedef __bf16 bf16x2_t __attribute__((ext_vector_type(2)));
__device__ __forceinline__ unsigned cvtpk_s(float lo,float hi){f32x2_t v={lo,hi};bf16x2_t b=__builtin_convertvector(v,bf16x2_t);return __builtin_bit_cast(unsigned,b);}
#define WAIT_BAR(N) asm volatile("s_waitcnt vmcnt(" #N ") lgkmcnt(0)\n\ts_barrier":::"memory")

__device__ __forceinline__ void qkt(f32x16&p0,f32x16&p1,const char*Kslot,const bf16x8*qr,const f32x16&c0,const f32x16&c1,int r32,int hi){
  const char*kb=Kslot+hi*1024+r32*16;
  #pragma unroll
  for(int d0=0;d0<4;++d0){
    const bf16x8 b0=*reinterpret_cast<const bf16x8*>(kb+d0*2048);
    const bf16x8 b1=*reinterpret_cast<const bf16x8*>(kb+d0*2048+512);
    if(d0==0){p0=__builtin_amdgcn_mfma_f32_32x32x16_bf16(b0,qr[0],c0,0,0,0);p1=__builtin_amdgcn_mfma_f32_32x32x16_bf16(b1,qr[0],c1,0,0,0);}
    else{p0=__builtin_amdgcn_mfma_f32_32x32x16_bf16(b0,qr[d0],p0,0,0,0);p1=__builtin_amdgcn_mfma_f32_32x32x16_bf16(b1,qr[d0],p1,0,0,0);}}
}
typedef __attribute__((address_space(3))) const char* lds_cptr;
typedef short v4i16_t __attribute__((ext_vector_type(4)));
__device__ __forceinline__ void kload8(bf16x8*kf,lds_cptr kp){
  kf[0]=*(const __attribute__((address_space(3))) bf16x8*)(kp);      kf[1]=*(const __attribute__((address_space(3))) bf16x8*)(kp+512);
  kf[2]=*(const __attribute__((address_space(3))) bf16x8*)(kp+2048); kf[3]=*(const __attribute__((address_space(3))) bf16x8*)(kp+2560);
  kf[4]=*(const __attribute__((address_space(3))) bf16x8*)(kp+4096); kf[5]=*(const __attribute__((address_space(3))) bf16x8*)(kp+4608);
  kf[6]=*(const __attribute__((address_space(3))) bf16x8*)(kp+6144); kf[7]=*(const __attribute__((address_space(3))) bf16x8*)(kp+6656);
}
__device__ __forceinline__ void kload2(bf16x8*kf,lds_cptr kp,int j){ kf[2*j]=*(const __attribute__((address_space(3))) bf16x8*)(kp+j*2048); kf[2*j+1]=*(const __attribute__((address_space(3))) bf16x8*)(kp+j*2048+512); }
__device__ __forceinline__ s16x4 vtr(lds_cptr p){ return __builtin_bit_cast(s16x4,__builtin_amdgcn_ds_read_tr16_b64_v4i16((__attribute__((address_space(3))) v4i16_t*)p)); }
__device__ __forceinline__ float rowmax(const f32x16&p0,const f32x16&p1){
  float a=max3f(p0[0],p0[1],p1[0]),b=max3f(p0[2],p0[3],p1[1]);a=max3f(a,p1[2],p1[3]);
  #pragma unroll
  for(int r=4;r<16;r+=4){a=max3f(a,p0[r],p0[r+1]);b=max3f(b,p0[r+2],p0[r+3]);a=max3f(a,p1[r],p1[r+1]);b=max3f(b,p1[r+2],p1[r+3]);}
  const float m=max2f(a,b);
  auto rr=__builtin_amdgcn_permlane32_swap(__float_as_uint(m),__float_as_uint(m),false,false);
  return max2f(__uint_as_float(rr[0]),__uint_as_float(rr[1]));
}
__device__ __forceinline__ void pv(f32x16*o,int vb,bf16x8 pa0,bf16x8 pa1,bf16x8 pa2,bf16x8 pa3){
  #pragma unroll
  for(int d0=0;d0<2;++d0){s16x4 lo[4],hi[4];
    #pragma unroll
    for(int ks=0;ks<4;++ks){
      asm volatile("ds_read_b64_tr_b16 %0,%1 offset:%c2":"=&v"(lo[ks]):"v"(vb),"i"(d0*4096+ks*1024):"memory");
      asm volatile("ds_read_b64_tr_b16 %0,%1 offset:%c2":"=&v"(hi[ks]):"v"(vb),"i"(d0*4096+ks*1024+512):"memory");}
    asm volatile("s_waitcnt lgkmcnt(0)":::"memory");SBAR();
    #define PK(k) (bf16x8){lo[k][0],lo[k][1],lo[k][2],lo[k][3],hi[k][0],hi[k][1],hi[k][2],hi[k][3]}
    o[d0]=__builtin_amdgcn_mfma_f32_32x32x16_bf16(pa0,PK(0),o[d0],0,0,0);
    o[d0]=__builtin_amdgcn_mfma_f32_32x32x16_bf16(pa1,PK(1),o[d0],0,0,0);
    o[d0]=__builtin_amdgcn_mfma_f32_32x32x16_bf16(pa2,PK(2),o[d0],0,0,0);
    o[d0]=__builtin_amdgcn_mfma_f32_32x32x16_bf16(pa3,PK(3),o[d0],0,0,0);
    #undef PK
  }
}

#ifndef ATTN_STORE16
#define ATTN_STORE16(p,v) (*(u32x4*)(p)=(v))
#endif
template<int THRL> __device__ __forceinline__ void attn_unit(int b,int h,int qb,const bf16*Q,const bf16*__restrict__ K,const bf16*__restrict__ V,bf16*O,char*shm,const __attribute__((address_space(3))) float*kbl){
  int tid_=threadIdx.x; asm volatile("":"+v"(tid_)); const int tid=tid_,lane=tid&63,r32=lane&31,hi=lane>>5; const int wid=__builtin_amdgcn_readfirstlane(tid>>6);
  const long rowbase=(long)b*SEQ; const int q0=qb*QB;
  const bf16*Qw=Q+(rowbase+q0+wid*QBLK)*DM+h*D;
  const bf16*Kh=K+rowbase*DM+h*D,*Vh=V+rowbase*DM+h*D;
  const unsigned lds0=(unsigned)(uintptr_t)shm;
  float*wsf=(float*)(shm+LDS_WS)+wid*64;
  const bf16*ksrc=Kh+(long)lane*DM+wid*8;
  const bf16*vsrc=Vh+(long)(16*(wid&3)+(lane>>2))*DM+(wid>>2)*32+(lane&3)*8;
  const unsigned kdst=lds0+LDS_K+wid*1024, vdst=lds0+LDS_V+wid*1024;
  #define DMA_K(t,slot) glds16(ksrc+(long)(t)*KVBLK*DM,(unsigned)__builtin_amdgcn_readfirstlane(kdst+(slot)))
  #define DMA_V(t,slot) glds16(vsrc+(long)(t)*KVBLK*DM,(unsigned)__builtin_amdgcn_readfirstlane(vdst+(slot)))
  const int vb0=(int)(lds0+LDS_V)+((lane>>4)&1)*32+(lane&3)*8+(4*hi+((lane&15)>>2))*64;
  const char*Kbase=shm+LDS_K; bf16x8 kf[8];
  const lds_cptr shm3=(lds_cptr)shm; const lds_cptr kp0=shm3+LDS_K+hi*1024+r32*16; const lds_cptr vp0=shm3+LDS_V+((lane>>4)&1)*32+(lane&3)*8+(4*hi+((lane&15)>>2))*64;
  const int NT=(q0+QB)/KVBLK;
  DMA_K(0,0);DMA_V(0,0);DMA_K(1,SLOTB);
  bf16x8 qr[4];
  #pragma unroll
  for(int d0=0;d0<4;++d0)qr[d0]=*reinterpret_cast<const bf16x8*>(&Qw[(long)r32*DM+d0*16+hi*8]);
  float mhat=0.f,l_reg=0.f;f32x16 o[2];o[0]=f32x16{};o[1]=f32x16{};float nm=0.f;
  const int qrel=wid*QBLK+r32;
  typedef float kb4_t __attribute__((ext_vector_type(4)));
  #define KB1(C,t,o) do{ const __attribute__((address_space(3))) float*kp_=kbl+64*(t)+4*hi+(o); \
    _Pragma("unroll") for(int j_=0;j_<4;++j_){ const kb4_t a_=*(const __attribute__((address_space(3))) kb4_t*)(kp_+8*j_); \
      _Pragma("unroll") for(int i_=0;i_<4;++i_){ C[4*j_+i_]=a_[i_]+nm; } } }while(0)
  #define CMASK(P0,P1,t) do{int jb_=(t)-(NT-4); if(jb_>=0)cmask(P0,P1,jb_,qrel,hi);}while(0)
  bool resc=false;
  #define START(P0,P1) do{ const float rm=rowmax(P0,P1); resc=false; \
    { const float dl=rm; mhat=fadd_s(mhat,dl); \
      _Pragma("unroll") for(int r=0;r<16;++r){P0[r]=fsub_s(P0[r],dl);P1[r]=fsub_s(P1[r],dl);} \
      nm=-mhat; } \
    _Pragma("unroll") for(int r=0;r<16;++r)P0[r]=__builtin_amdgcn_exp2f(P0[r]); }while(0)
  #define RESC() do{ if(resc){ asm volatile("s_waitcnt lgkmcnt(0)":::"memory"); \
      _Pragma("unroll") for(int d_=0;d_<2;++d_) _Pragma("unroll") for(int r=0;r<16;++r)o[d_][r]*=wsf[crow(r,hi)]; } }while(0)
  f32x16 pA0,pA1,pB0,pB1;
  int sl_prev=0,sl_cur=0,sl_next=SLOTB;
  #define ROT() do{sl_prev=sl_cur;sl_cur=sl_next;sl_next=(sl_next==(NSLOT-1)*SLOTB)?0:sl_next+SLOTB;}while(0)
  DMA_K(2,2*SLOTB);
  WAIT_BAR(3);
  { f32x16 cz0,cz1; KB1(cz0,0,0); KB1(cz1,0,32); qkt(pA0,pA1,Kbase,qr,cz0,cz1,r32,hi); } asm volatile("s_nop 15\n\ts_nop 7":"+v"(pA0),"+v"(pA1));CMASK(pA0,pA1,0);
  START(pA0,pA1);
  _Pragma("unroll") for(int r=0;r<16;++r)pA1[r]=__builtin_amdgcn_exp2f(pA1[r]);
  WAIT_BAR(0);
  DMA_K(3,0);DMA_V(1,SLOTB);
  ROT();
  kload8(kf,kp0+sl_cur);
  WAIT_BAR(2);
  s16x4 vlo[8],vhi[8]; u32x4 pw0,pw1,pw2,pw3;
  #define PKW(P,B) cvtpk_s(P[B],P[B+1])
  #define PAF(k) __builtin_bit_cast(bf16x8,pw##k)
  #define VFR(i) (bf16x8){vlo[i][0],vlo[i][1],vlo[i][2],vlo[i][3],vhi[i][0],vhi[i][1],vhi[i][2],vhi[i][3]}
  #define PIN(x) asm volatile("":"+v"(x))
  #define MX3(a,b,c) __builtin_fmaxf(__builtin_fmaxf((a),(b)),(c))
  #define GAPA(MF,A0,A1,A2,A3,W0,W1,PW) do{ MF; sacc+=A0; sacc+=A1; sacc+=A2; sacc+=A3; PIN(sacc); W0; W1; PIN(PW); SBAR(); }while(0)
  #define EX(v) __builtin_amdgcn_exp2f(v)
  #define GAPB(MF,X,B) do{ MF; X[B]=EX(X[B]); X[B+1]=EX(X[B+1]); X[B+2]=EX(X[B+2]); X[B+3]=EX(X[B+3]); PIN(X); SBAR(); }while(0)
  #define VRD(i) do{ vlo[i]=vtr(vp_+(((i)>>2)*4096+((i)&3)*1024)); vhi[i]=vtr(vp_+(((i)>>2)*4096+((i)&3)*1024+512)); }while(0)
  #define KRD(G,j) do{ if(G){ kload2(kf,kp0+sl_next,j); SBAR(); } }while(0)
  #define STEP(C0,C1,P0,P1,t,GK,GV,GL) do{ SBAR(); \
    const lds_cptr vp_=vp0+sl_prev; KB1(C0,t,0); SBAR(); \
    VRD(0); SBAR(); float sacc=(P0[0]+P0[1]); \
    GAPA(C0=__builtin_amdgcn_mfma_f32_32x32x16_bf16(kf[0],qr[0],C0,0,0,0), P0[2],P0[3],P0[4],P0[5],     pw0[0]=PKW(P0,0), pw0[1]=PKW(P0,2), pw0); \
    KB1(C1,t,32); VRD(4); SBAR(); GAPA(C1=__builtin_amdgcn_mfma_f32_32x32x16_bf16(kf[1],qr[0],C1,0,0,0), P0[6],P0[7],P0[8],P0[9],     pw0[2]=PKW(P0,4), pw0[3]=PKW(P0,6), pw0); \
    VRD(1); SBAR(); GAPA(C0=__builtin_amdgcn_mfma_f32_32x32x16_bf16(kf[2],qr[1],C0,0,0,0),   P0[10],P0[11],P0[12],P0[13], pw1[0]=PKW(P0,8), pw1[1]=PKW(P0,10), pw1); \
    VRD(5); SBAR(); GAPA(C1=__builtin_amdgcn_mfma_f32_32x32x16_bf16(kf[3],qr[1],C1,0,0,0),   P0[14],P0[15],P1[0],P1[1],   pw1[2]=PKW(P0,12),pw1[3]=PKW(P0,14), pw1); \
    VRD(2); SBAR(); GAPA(C0=__builtin_amdgcn_mfma_f32_32x32x16_bf16(kf[4],qr[2],C0,0,0,0),   P1[2],P1[3],P1[4],P1[5],     pw2[0]=PKW(P1,0), pw2[1]=PKW(P1,2), pw2); \
    VRD(6); SBAR(); GAPA(C1=__builtin_amdgcn_mfma_f32_32x32x16_bf16(kf[5],qr[2],C1,0,0,0),   P1[6],P1[7],P1[8],P1[9],     pw2[2]=PKW(P1,4), pw2[3]=PKW(P1,6), pw2); \
    VRD(3); SBAR(); GAPA(C0=__builtin_amdgcn_mfma_f32_32x32x16_bf16(kf[6],qr[3],C0,0,0,0),   P1[10],P1[11],P1[12],P1[13], pw3[0]=PKW(P1,8), pw3[1]=PKW(P1,10), pw3); \
    VRD(7); SBAR(); GAPA(C1=__builtin_amdgcn_mfma_f32_32x32x16_bf16(kf[7],qr[3],C1,0,0,0),   P1[14],P1[15],0.f,0.f,       pw3[2]=PKW(P1,12),pw3[3]=PKW(P1,14), pw3); \
    l_reg+=sacc; \
    if(GK){DMA_K((t)+3,sl_cur);} if(GV){DMA_V((t)+1,sl_next);} \
    CMASK(C0,C1,t); \
    { float a=MX3(C0[0],C0[1],C1[0]),b=MX3(C0[2],C0[3],C1[1]); a=MX3(a,C1[2],C1[3]); \
      _Pragma("unroll") for(int r=4;r<16;r+=4){a=MX3(a,C0[r],C0[r+1]);b=MX3(b,C0[r+2],C0[r+3]);a=MX3(a,C1[r],C1[r+1]);b=MX3(b,C1[r+2],C1[r+3]);} \
      float rm=__builtin_fmaxf(a,b); { auto rr=__builtin_amdgcn_permlane32_swap(__float_as_uint(rm),__float_as_uint(rm),false,false); rm=__builtin_fmaxf(__uint_as_float(rr[0]),__uint_as_float(rr[1])); } \
      resc=false; \
      if(__builtin_expect(__any(rm>(float)THRL),0)){ const float dl=__builtin_fmaxf(rm,0.f); mhat+=dl; \
        _Pragma("unroll") for(int r=0;r<16;++r){C0[r]-=dl;C1[r]-=dl;} \
        nm=-mhat; \
        const float f=__builtin_amdgcn_exp2f(-dl); l_reg*=f; if(hi==0)wsf[r32]=f; resc=true; } } \
    SBAR(); \
    GAPB(o[0]=__builtin_amdgcn_mfma_f32_32x32x16_bf16(PAF(0),VFR(0),o[0],0,0,0), C0,0); \
    GAPB(o[1]=__builtin_amdgcn_mfma_f32_32x32x16_bf16(PAF(0),VFR(4),o[1],0,0,0), C0,4); \
    KRD(GL,0); GAPB(o[0]=__builtin_amdgcn_mfma_f32_32x32x16_bf16(PAF(1),VFR(1),o[0],0,0,0), C0,8); \
    KRD(GL,1); GAPB(o[1]=__builtin_amdgcn_mfma_f32_32x32x16_bf16(PAF(1),VFR(5),o[1],0,0,0), C0,12); \
    KRD(GL,2); GAPB(o[0]=__builtin_amdgcn_mfma_f32_32x32x16_bf16(PAF(2),VFR(2),o[0],0,0,0), C1,0); \
    KRD(GL,3); GAPB(o[1]=__builtin_amdgcn_mfma_f32_32x32x16_bf16(PAF(2),VFR(6),o[1],0,0,0), C1,4); \
    GAPB(o[0]=__builtin_amdgcn_mfma_f32_32x32x16_bf16(PAF(3),VFR(3),o[0],0,0,0), C1,8); \
    GAPB(o[1]=__builtin_amdgcn_mfma_f32_32x32x16_bf16(PAF(3),VFR(7),o[1],0,0,0), C1,12); \
    }while(0)
  int t=1;
  #undef CMASK
  #define CMASK(P0,P1,t) do{}while(0)
  for(;t+5<NT;t+=2){
    STEP(pB0,pB1,pA0,pA1,t,true,true,true);     WAIT_BAR(2); RESC(); ROT();
    STEP(pA0,pA1,pB0,pB1,t+1,true,true,true);   WAIT_BAR(2); RESC(); ROT();
  }
  #undef CMASK
  #define CMASK(P0,P1,t) do{int jb_=(t)-(NT-4); if(jb_>=0)cmask(P0,P1,jb_,qrel,hi);}while(0)
  #define ENDW(tt) do{ if((tt)+3<NT){WAIT_BAR(2);} else if((tt)+2<NT){WAIT_BAR(1);} else {WAIT_BAR(0);} }while(0)
  for(;t+1<NT;t+=2){
    STEP(pB0,pB1,pA0,pA1,t,(t+3<NT),(t+1<NT),(t+1<NT));       ENDW(t);   RESC(); ROT();
    STEP(pA0,pA1,pB0,pB1,t+1,(t+4<NT),(t+2<NT),(t+2<NT));     ENDW(t+1); RESC(); ROT();
  }
  STEP(pB0,pB1,pA0,pA1,NT-1,false,false,false); RESC();
  { float sacc=pB0[0]+pB0[1]; _Pragma("unroll") for(int r=2;r<16;++r)sacc+=pB0[r]; _Pragma("unroll") for(int r=0;r<16;++r)sacc+=pB1[r]; l_reg+=sacc;
    pw0=(u32x4){PKW(pB0,0),PKW(pB0,2),PKW(pB0,4),PKW(pB0,6)};pw1=(u32x4){PKW(pB0,8),PKW(pB0,10),PKW(pB0,12),PKW(pB0,14)};pw2=(u32x4){PKW(pB1,0),PKW(pB1,2),PKW(pB1,4),PKW(pB1,6)};pw3=(u32x4){PKW(pB1,8),PKW(pB1,10),PKW(pB1,12),PKW(pB1,14)};
    SBAR(); pv(o,vb0+sl_cur,PAF(0),PAF(1),PAF(2),PAF(3)); }
  #undef PKW
  #undef PAF
  #undef VFR
  #undef PIN
  #undef MX3
  #undef GAPA
  #undef GAPB
  #undef EX
  #undef VRD
  #undef KRD
  #undef STEP
  #undef ENDW
  {auto rr=__builtin_amdgcn_permlane32_swap(__float_as_uint(l_reg),__float_as_uint(l_reg),false,false);l_reg=__uint_as_float(rr[0])+__uint_as_float(rr[1]);}
  if(hi==0)wsf[32+r32]=l_reg;asm volatile("s_waitcnt lgkmcnt(0)":::"memory");
  float rli[16];
  #pragma unroll
  for(int r=0;r<16;++r)rli[r]=__builtin_amdgcn_rcpf(wsf[32+crow(r,hi)]);
  bf16*Ow=O+(rowbase+q0+wid*QBLK)*DM+h*D;
  { bf16*stg=(bf16*)(shm+LDS_OST)+wid*2048;
    #pragma unroll
    for(int r=0;r<16;++r){const int orow=crow(r,hi);
      #pragma unroll
      for(int d0=0;d0<2;++d0)stg[orow*64+d0*32+r32]=__float2bfloat16(o[d0][r]*rli[r]);}
    asm volatile("s_waitcnt lgkmcnt(0)":::"memory");
    #pragma unroll
    for(int i=0;i<4;++i){const int row=i*8+(lane>>3),ch=lane&7; const u32x4 v=*(const u32x4*)(stg+row*64+ch*8); ATTN_STORE16(Ow+(long)row*DM+ch*8,v);} }
  asm volatile("s_waitcnt lgkmcnt(0)\n\ts_barrier":::"memory");
  #undef DMA_K
  #undef DMA_V
  #undef KB1
  #undef CMASK
  #undef START
  #undef RESC
  #undef ROT
}
constexpr int ATTN_LDS_BYTES=LDS_BYTES;
struct AttnTensors { const bf16* Q; const bf16* K; const bf16* V; bf16* O; };
struct AttnUnit { int bh; int qb; };
#undef SBAR
#undef WAIT_BAR
}
#define GAS __attribute__((address_space(1)))
#define LAS __attribute__((address_space(3)))
typedef unsigned short bf16;
typedef unsigned v4u __attribute__((ext_vector_type(4)));
typedef float f32x4 __attribute__((ext_vector_type(4)));
typedef short bf16x8 __attribute__((ext_vector_type(8)));
typedef GAS unsigned gu32;
typedef GAS unsigned long long gu64;
#define RLX_AGENT __ATOMIC_RELAXED, __HIP_MEMORY_SCOPE_AGENT
#define LDS_WAIT() asm volatile("s_waitcnt lgkmcnt(0)" ::: "memory")
#define VM_WAIT() asm volatile("s_waitcnt vmcnt(0)" ::: "memory")
__device__ __forceinline__ unsigned long long rt() { return __builtin_amdgcn_s_memrealtime(); }
__device__ __forceinline__ unsigned f2bf(float f) { unsigned u = __builtin_bit_cast(unsigned, f); return (u + 0x7fffu + ((u >> 16) & 1u)) >> 16; }
__device__ __forceinline__ unsigned pk2(float lo, float hi) { return f2bf(lo) | (f2bf(hi) << 16); }

#define XB_TMO      128
#define XB_XCNT(j)  (256  + 64 * (j))
#define XB_XSUB(j)  (1280 + 64 * (j))
#define XB_XGEN(j)  (2304 + 64 * (j))
#define XB_TOP      3328
#define XB_TOPGEN   3392
#define XCD_BAR_WORDS 3456
#define XB_SPIN_CAP (1u << 18)

__device__ __forceinline__ unsigned xb_ld(unsigned* p)              { return __hip_atomic_load(p, __ATOMIC_RELAXED, __HIP_MEMORY_SCOPE_AGENT); }
__device__ __forceinline__ unsigned xb_add(unsigned* p, unsigned v) { return __hip_atomic_fetch_add(p, v, __ATOMIC_RELAXED, __HIP_MEMORY_SCOPE_AGENT); }
__device__ __forceinline__ unsigned xb_xcc_id() { return (unsigned)__builtin_amdgcn_s_getreg((3 << 11) | 20) & 0xFu; }
#define XB_SPIN(cond, bar) do { unsigned _sp = 0; while (cond) { __builtin_amdgcn_s_sleep(1); \
    if ((++_sp & 255u) == 0u) { if (xb_ld(&(bar)[XB_TMO])) break; if (_sp > XB_SPIN_CAP) { atomicAdd(&(bar)[XB_TMO], 1u); break; } } } } while (0)

struct XcdBarrier {
    unsigned* bar; unsigned x;
    volatile LAS unsigned* st;
};

__device__ __forceinline__ XcdBarrier xcd_barrier_post(unsigned* bar, volatile LAS unsigned* st) {
    XcdBarrier b; b.bar = bar; b.x = xb_xcc_id(); b.st = st;
    if (threadIdx.x == 0) (void)xb_add(&bar[XB_XCNT(b.x)], 1u);
    return b;
}
__device__ __forceinline__ void xcd_barrier_complete(unsigned* bar, unsigned x, unsigned& nloc, unsigned& nx) {
    const unsigned G = gridDim.x * gridDim.y * gridDim.z;
    unsigned sum, cnt, mine, sp = 0u;
    for (;;) {
        sum = 0u; cnt = 0u; mine = 0u;
#pragma unroll
        for (unsigned j = 0; j < 16; ++j) { const unsigned c = xb_ld(&bar[XB_XCNT(j)]); sum += c; cnt += (c > 0u) ? 1u : 0u; mine = (j == x) ? c : mine; }
        if (sum == G) break;
        __builtin_amdgcn_s_sleep(1);
        if ((++sp & 255u) == 0u) { if (xb_ld(&bar[XB_TMO])) break; if (sp > XB_SPIN_CAP) { atomicAdd(&bar[XB_TMO], 1u); break; } }
    }
    nloc = mine > 0u ? mine : 1u; nx = cnt > 0u ? cnt : 1u;
}

__device__ __forceinline__ void xcd_barrier(const XcdBarrier& b) {
    asm volatile("s_waitcnt vmcnt(0)" ::: "memory");
    __syncthreads();
    if (threadIdx.x == 0) {
        unsigned* bar = b.bar;
        __builtin_amdgcn_s_waitcnt(0);
        unsigned nloc = b.st[0], nx = b.st[1];
        if (nloc == 0u) { xcd_barrier_complete(bar, b.x, nloc, nx); b.st[0] = nloc; b.st[1] = nx; }
        const unsigned old = xb_add(&bar[XB_XSUB(b.x)], 1u);
        const unsigned gen = old / nloc;
        if (old + 1u == (gen + 1u) * nloc) {
            __builtin_amdgcn_fence(__ATOMIC_RELEASE, "agent");
            asm volatile("s_waitcnt vmcnt(0)" ::: "memory");
            const unsigned og = xb_add(&bar[XB_TOP], 1u);
            const unsigned tg = og / nx;
            if (og + 1u == (tg + 1u) * nx) xb_add(&bar[XB_TOPGEN], 1u);
            else XB_SPIN(xb_ld(&bar[XB_TOPGEN]) == tg, bar);
            __builtin_amdgcn_fence(__ATOMIC_ACQUIRE, "agent");
            xb_add(&bar[XB_XGEN(b.x)], 1u);
            asm volatile("s_waitcnt vmcnt(0)" ::: "memory");
        } else {
            XB_SPIN(xb_ld(&bar[XB_XGEN(b.x)]) == gen, bar);
            __builtin_amdgcn_fence(__ATOMIC_ACQUIRE, "agent");
            asm volatile("s_waitcnt vmcnt(0)" ::: "memory");
        }
    }
    __syncthreads();
}
#include <hip/hip_cooperative_groups.h>
namespace cg = cooperative_groups;

#ifndef REP_SCAN
#define REP_SCAN 1
#endif
#ifndef REP_PREP
#define REP_PREP 1
#endif
#ifndef REP_NORM
#define REP_NORM 1
#endif
#ifndef REP_P0
#define REP_P0 1
#endif
#ifndef MK_MULTI
#define MK_MULTI 0
#endif

constexpr int NWAVES = 8, NTHR = 512;
constexpr int BATCH = 16, SEQ = 2048, D = 1024, M = BATCH * SEQ, NH = 16, FFH = 2816, MODW = 6 * D;
constexpr int INW = 3 * D + 16;
constexpr int NCH = SEQ / 64;
constexpr float EPS = 1e-6f, LOG2E = 1.4426950408889634f;

constexpr size_t MiB = 1u << 20;
constexpr size_t WS_CTL = 0, CTL_ZERO_BYTES = 1 * MiB;
constexpr size_t WS_WIN0 = 2 * MiB, WS_WOUT0 = 8 * MiB, WS_WIN1 = 10 * MiB, WS_WOUT1 = 16 * MiB;
constexpr size_t WS_FIN0 = 18 * MiB, WS_FIN1 = 29 * MiB, WS_FOUT0 = 40 * MiB, WS_FOUT1 = 46 * MiB;
constexpr size_t WS_MOD = 52 * MiB;
constexpr size_t WS_LOGF = 53 * MiB;
constexpr size_t WS_ALR = 55 * MiB;
constexpr size_t WS_DEC = 57 * MiB;
constexpr size_t WS_XN = 64 * MiB;
constexpr size_t WS_BIG = 128 * MiB;
constexpr size_t WS_GQI = 320 * MiB, WS_GKI = 352 * MiB, WS_GKDT = 384 * MiB, WS_GVT = 416 * MiB, WS_END = 480 * MiB;

constexpr int RING_BYTES = 131072;
constexpr int MISC_OFF = RING_BYTES + 320;
constexpr int CW_BAR = 4096;
constexpr int LDS_BYTES = 147456;

struct Args { const float* in[17]; float* out; unsigned char* ws; int ph_lo, ph_hi; };

struct Frame {
    LAS unsigned char* lds;
    int tid, lane, wave, vcu, G;
    const float *x, *c, *ada_w, *ada_b, *norm1_g, *norm2_g, *ffn_w_in, *ffn_w_out, *fox_w_in, *fox_b_f, *fox_w_out, *gla_w_in, *gla_w_a2, *gla_b_a, *gla_g_o, *gla_w_out, *final_g;
    float* out; unsigned char* ws;
    float *MOD, *LOGF, *ALR, *DEC;
    bf16 *XN, *BIG, *GQI, *GKI, *GKDT, *GVT;
};

__device__ __forceinline__ float wave_sum(float v) {
#pragma unroll
    for (int o = 1; o < 64; o <<= 1) v += __shfl_xor(v, o);
    return v;
}
__device__ __forceinline__ float bf2f(unsigned short h) { return __uint_as_float((unsigned)h << 16); }
__device__ __forceinline__ float log_sigmoid(float z) { return fminf(z, 0.f) - log1pf(__expf(-fabsf(z))); }
__device__ __forceinline__ float silu_f(float g) { return g * __builtin_amdgcn_rcpf(1.f + __expf(-g)); }

__device__ __forceinline__ void frame_tid(Frame& F) { int t = threadIdx.x; asm volatile("" : "+v"(t)); F.tid = t; F.lane = t & 63; F.wave = __builtin_amdgcn_readfirstlane(t >> 6); }
__device__ __forceinline__ void transpose_item(const float* W, int ldw, int K, bf16* WT, int k0, int n0, int drow0, LAS float* scr, int lane) {
#pragma unroll 8
    for (int i = 0; i < 32; ++i) { const int kk = 2 * i + (lane >> 5); scr[kk * 33 + (lane & 31)] = W[(size_t)(k0 + kk) * ldw + n0 + (lane & 31)]; }
    LDS_WAIT(); asm volatile("" ::: "memory");
    const int c = lane & 7;
#pragma unroll
    for (int j = 0; j < 4; ++j) { const int n = (lane >> 3) + 8 * j; const LAS float* s = scr + (8 * c) * 33 + n;
        v4u o; o.x = pk2(s[0 * 33], s[1 * 33]); o.y = pk2(s[2 * 33], s[3 * 33]); o.z = pk2(s[4 * 33], s[5 * 33]); o.w = pk2(s[6 * 33], s[7 * 33]);
        *(GAS v4u*)(WT + (size_t)(drow0 + n) * K + k0 + 8 * c) = o; }
    LDS_WAIT(); asm volatile("" ::: "memory");
}
__device__ __forceinline__ int ffn_in_row(int n0) { const int j = n0 < FFH ? n0 : n0 - FFH; return (j >> 7) * 256 + (n0 < FFH ? 0 : 128) + (j & 127); }

__device__ __forceinline__ void p0_prologue(Frame& F) {
    LAS float* cact = (LAS float*)F.lds;
    LAS float* red = (LAS float*)(F.lds + 65536);
    if (F.vcu < 192) {
        for (int e = F.tid; e < 16 * D; e += NTHR) { const int b = e >> 10, k = e & 1023; const float cv = F.c[e]; cact[k * 16 + b] = cv / (1.f + __expf(-cv)); }
        __syncthreads();
        for (int task = F.vcu; task < 192; task += F.G) {
            const int l = task / 96, j0 = (task % 96) * 64;
            const float* W = F.ada_w + (size_t)l * D * MODW + j0 + F.lane;
            float acc[16];
#pragma unroll
            for (int b = 0; b < 16; ++b) acc[b] = 0.f;
            const int kb = F.wave * 128;
#pragma unroll 4
            for (int kk = 0; kk < 128; ++kk) { const int k = kb + kk; const float wv = W[(size_t)k * MODW];
                const LAS f32x4* cp = (const LAS f32x4*)(cact + k * 16);
#pragma unroll
                for (int q = 0; q < 4; ++q) { const f32x4 cv = cp[q]; acc[4 * q + 0] += cv.x * wv; acc[4 * q + 1] += cv.y * wv; acc[4 * q + 2] += cv.z * wv; acc[4 * q + 3] += cv.w * wv; } }
#pragma unroll
            for (int b = 0; b < 16; ++b) red[(F.wave * 16 + b) * 64 + F.lane] = acc[b];
            __syncthreads();
            for (int o = F.tid; o < 1024; o += NTHR) { const int b = o >> 6, col = o & 63; float s = F.ada_b[l * MODW + j0 + col];
#pragma unroll
                for (int w = 0; w < 8; ++w) s += red[(w * 16 + b) * 64 + col];
                F.MOD[((size_t)l * 16 + b) * MODW + j0 + col] = s; }
            __syncthreads();
        }
    }
    __syncthreads();
    LAS float* scr = (LAS float*)(F.lds + F.wave * 16384);
    const int gw = F.vcu * NWAVES + F.wave, NGW = F.G * NWAVES;
    constexpr int I_IN = 16 * 96, I_OUT = 16 * 32, I_FI = 16 * 176, I_FO = 44 * 32;
    constexpr int NITEMS = 2 * I_IN + 2 * I_OUT + 2 * I_FI + 2 * I_FO;
    for (int it = gw; it < NITEMS; it += NGW) {
        int r = it;
        if (r < I_IN) { transpose_item(F.fox_w_in, INW, D, (bf16*)(F.ws + WS_WIN0), 64 * (r / 96), 32 * (r % 96), 32 * (r % 96), scr, F.lane); continue; } r -= I_IN;
        if (r < I_IN) { transpose_item(F.gla_w_in, INW, D, (bf16*)(F.ws + WS_WIN1), 64 * (r / 96), 32 * (r % 96), 32 * (r % 96), scr, F.lane); continue; } r -= I_IN;
        if (r < I_OUT) { transpose_item(F.fox_w_out, D, D, (bf16*)(F.ws + WS_WOUT0), 64 * (r / 32), 32 * (r % 32), 32 * (r % 32), scr, F.lane); continue; } r -= I_OUT;
        if (r < I_OUT) { transpose_item(F.gla_w_out, D, D, (bf16*)(F.ws + WS_WOUT1), 64 * (r / 32), 32 * (r % 32), 32 * (r % 32), scr, F.lane); continue; } r -= I_OUT;
        if (r < 2 * I_FI) { const int l = r / I_FI; r -= l * I_FI; const int n0 = 32 * (r % 176);
            transpose_item(F.ffn_w_in + (size_t)l * D * 2 * FFH, 2 * FFH, D, (bf16*)(F.ws + (l ? WS_FIN1 : WS_FIN0)), 64 * (r / 176), n0, ffn_in_row(n0), scr, F.lane); continue; } r -= 2 * I_FI;
        { const int l = r / I_FO; r -= l * I_FO;
            transpose_item(F.ffn_w_out + (size_t)l * FFH * D, D, FFH, (bf16*)(F.ws + (l ? WS_FOUT1 : WS_FOUT0)), 64 * (r / 32), 32 * (r % 32), 32 * (r % 32), scr, F.lane); }
    }
}

__device__ __forceinline__ float bfly32(float (&v)[32], int lane) {
#define BFLY_STEP(HALF, OFF) { const bool up = (lane & (OFF)) != 0; _Pragma("unroll") for (int i = 0; i < (HALF); ++i) { const float keep = up ? v[i + (HALF)] : v[i]; const float send = up ? v[i] : v[i + (HALF)]; v[i] = keep + __shfl_xor(send, (OFF)); } }
    BFLY_STEP(16, 32) BFLY_STEP(8, 16) BFLY_STEP(4, 8) BFLY_STEP(2, 4) BFLY_STEP(1, 2)
#undef BFLY_STEP
    return v[0] + __shfl_xor(v[0], 1);
}
__device__ __forceinline__ void norm_pass(Frame& F, const float* xin, const float* gvec, const float* modl, int shc, int mode, const float* wx) {
    LAS float* wT = (LAS float*)F.lds;
    if (mode != 2) {
        for (int e = F.tid; e < 16 * D; e += NTHR) { const int k = e >> 4, j = e & 15; wT[j * D + k] = wx[(size_t)k * INW + 3 * D + j]; }
    }
    __syncthreads();
    const int gw = F.vcu * NWAVES + F.wave, NGW = F.G * NWAVES, lane = F.lane;
    for (int r0 = gw * 16; r0 < M; r0 += NGW * 16) {
        const int b = r0 / SEQ;
        const float* mb = modl + (size_t)b * MODW;
        f32x4 wk[4], sk[4];
#pragma unroll
        for (int j = 0; j < 4; ++j) { const int k = 4 * lane + 256 * j; const f32x4 g = *(const f32x4*)(gvec + k), sc = *(const f32x4*)(mb + (shc + 1) * D + k);
            wk[j] = g * (sc + 1.0f); sk[j] = *(const f32x4*)(mb + shc * D + k); }
#pragma unroll 1
        for (int i = 0; i < 16; i += 2) {
            const int ra = r0 + i, rb = ra + 1;
            const GAS f32x4* xa = (const GAS f32x4*)(xin + (size_t)ra * D) + lane; const GAS f32x4* xb = (const GAS f32x4*)(xin + (size_t)rb * D) + lane;
            f32x4 va[4], vb[4]; float sa = 0.f, sb = 0.f;
#pragma unroll
            for (int j = 0; j < 4; ++j) { va[j] = xa[64 * j]; vb[j] = xb[64 * j]; }
#pragma unroll
            for (int j = 0; j < 4; ++j) { sa += (va[j].x * va[j].x + va[j].y * va[j].y) + (va[j].z * va[j].z + va[j].w * va[j].w); sb += (vb[j].x * vb[j].x + vb[j].y * vb[j].y) + (vb[j].z * vb[j].z + vb[j].w * vb[j].w); }
            const float ra_ = 1.0f / sqrtf(wave_sum(sa) * (1.f / D) + EPS), rb_ = 1.0f / sqrtf(wave_sum(sb) * (1.f / D) + EPS);
            GAS unsigned long long* oa = (GAS unsigned long long*)(F.XN + (size_t)ra * D) + lane; GAS unsigned long long* ob = (GAS unsigned long long*)(F.XN + (size_t)rb * D) + lane;
#pragma unroll
            for (int j = 0; j < 4; ++j) { va[j] = va[j] * ra_ * wk[j] + sk[j]; vb[j] = vb[j] * rb_ * wk[j] + sk[j];
                oa[64 * j] = (unsigned long long)pk2(va[j].x, va[j].y) | ((unsigned long long)pk2(va[j].z, va[j].w) << 32);
                ob[64 * j] = (unsigned long long)pk2(vb[j].x, vb[j].y) | ((unsigned long long)pk2(vb[j].z, vb[j].w) << 32); }
            if (mode != 2) {
                float acc[32];
#pragma unroll
                for (int hd = 0; hd < 16; ++hd) { float pa = 0.f, pb = 0.f;
#pragma unroll
                    for (int j = 0; j < 4; ++j) { const f32x4 w = *(const LAS f32x4*)(wT + hd * D + 4 * lane + 256 * j);
                        pa += (va[j].x * w.x + va[j].y * w.y) + (va[j].z * w.z + va[j].w * w.w); pb += (vb[j].x * w.x + vb[j].y * w.y) + (vb[j].z * w.z + vb[j].w * w.w); }
                    acc[hd] = pa; acc[16 + hd] = pb; if (hd & 1) asm volatile("" ::: "memory"); }
                const float tot = bfly32(acc, lane);
                const int idx = ((lane >> 5) & 1) * 16 + ((lane >> 4) & 1) * 8 + ((lane >> 3) & 1) * 4 + ((lane >> 2) & 1) * 2 + ((lane >> 1) & 1);
                if ((lane & 1) == 0) { const int row = (idx >= 16) ? rb : ra, hd = idx & 15;
                    if (mode == 0) F.LOGF[((size_t)(b * NH + hd)) * SEQ + (row - b * SEQ)] = log_sigmoid(tot + F.fox_b_f[hd]);
                    else F.ALR[(size_t)row * 16 + hd] = tot; }
            }
        }
    }
}
__device__ __forceinline__ void final_norm(Frame& F) {
    const int gw = F.vcu * NWAVES + F.wave, NGW = F.G * NWAVES, lane = F.lane;
    f32x4 g[4];
#pragma unroll
    for (int j = 0; j < 4; ++j) g[j] = *(const f32x4*)(F.final_g + 4 * lane + 256 * j);
    for (int m = gw; m < M; m += NGW) {
        GAS f32x4* xr = (GAS f32x4*)(F.out + (size_t)m * D) + lane; f32x4 v[4]; float s = 0.f;
#pragma unroll
        for (int j = 0; j < 4; ++j) { v[j] = xr[64 * j]; s += (v[j].x * v[j].x + v[j].y * v[j].y) + (v[j].z * v[j].z + v[j].w * v[j].w); }
        const float r = 1.0f / sqrtf(wave_sum(s) * (1.f / D) + EPS);
#pragma unroll
        for (int j = 0; j < 4; ++j) xr[64 * j] = v[j] * r * g[j];
    }
}
__device__ __forceinline__ void gla_onorm(Frame& F) {
    const int gw = F.vcu * NWAVES + F.wave, NGW = F.G * NWAVES, lane = F.lane;
    float go[16];
#pragma unroll
    for (int i = 0; i < 16; ++i) go[i] = F.gla_g_o[16 * lane + i];
    for (int m = gw; m < M; m += NGW) {
        const bf16* orow = F.BIG + (size_t)m * 3072 + 16 * lane;
        const v4u o0 = *(const GAS v4u*)orow, o1 = *(const GAS v4u*)(orow + 8), r0 = *(const GAS v4u*)(orow + 2048), r1 = *(const GAS v4u*)(orow + 2056);
        float ov[16], rv[16];
#pragma unroll
        for (int q = 0; q < 4; ++q) { ov[2 * q] = __uint_as_float(o0[q] << 16); ov[2 * q + 1] = __uint_as_float(o0[q] & 0xffff0000u); ov[8 + 2 * q] = __uint_as_float(o1[q] << 16); ov[8 + 2 * q + 1] = __uint_as_float(o1[q] & 0xffff0000u);
            rv[2 * q] = __uint_as_float(r0[q] << 16); rv[2 * q + 1] = __uint_as_float(r0[q] & 0xffff0000u); rv[8 + 2 * q] = __uint_as_float(r1[q] << 16); rv[8 + 2 * q + 1] = __uint_as_float(r1[q] & 0xffff0000u); }
        float ss = 0.f;
#pragma unroll
        for (int i = 0; i < 16; ++i) ss += ov[i] * ov[i];
        ss += __shfl_xor(ss, 1); ss += __shfl_xor(ss, 2); ss += __shfl_xor(ss, 4); ss += __shfl_xor(ss, 8);
        const float rs = 1.0f / sqrtf(ss * (1.f / 256.f) + EPS);
        v4u w0, w1;
#pragma unroll
        for (int q = 0; q < 4; ++q) {
            w0[q] = pk2(ov[2 * q] * rs * go[2 * q] * silu_f(rv[2 * q]), ov[2 * q + 1] * rs * go[2 * q + 1] * silu_f(rv[2 * q + 1]));
            w1[q] = pk2(ov[8 + 2 * q] * rs * go[8 + 2 * q] * silu_f(rv[8 + 2 * q]), ov[8 + 2 * q + 1] * rs * go[8 + 2 * q + 1] * silu_f(rv[8 + 2 * q + 1])); }
        bf16* xo = F.XN + (size_t)m * D + 16 * lane;
        *(GAS v4u*)xo = w0; *(GAS v4u*)(xo + 8) = w1;
    }
}

namespace pg8 {
struct EpiSwiGLU {
    static constexpr bool PERM = true, AFTER_DRAIN = false;
    bf16_t* O; int ldc;
    __device__ __forceinline__ void operator()(const f32x4 (&acc)[2][2][4][2], const Unit& u, int wr, int wc, int fr, int fq) const {
        const int row0 = u.pm * BM + wr * 64 + fr, col0 = u.pn * HALF + wc * 32 + 8 * fq;
#pragma unroll
        for (int ai = 0; ai < 2; ++ai)
#pragma unroll
            for (int m = 0; m < 4; ++m) { bf16_t* rowp = O + (size_t)(row0 + ai * HALF + m * 16) * ldc + col0;
                const f32x4 g0 = acc[ai][0][m][0], g1 = acc[ai][0][m][1], u0 = acc[ai][1][m][0], u1 = acc[ai][1][m][1];
                u32x4 w; w.x = cvt_pk_bf16(silu_f(g0[0]) * u0[0], silu_f(g0[1]) * u0[1]); w.y = cvt_pk_bf16(silu_f(g0[2]) * u0[2], silu_f(g0[3]) * u0[3]);
                w.z = cvt_pk_bf16(silu_f(g1[0]) * u1[0], silu_f(g1[1]) * u1[1]); w.w = cvt_pk_bf16(silu_f(g1[2]) * u1[2], silu_f(g1[3]) * u1[3]);
                *(u32x4*)rowp = w; }
    }
};
struct EpiResGate {
    static constexpr bool PERM = false, AFTER_DRAIN = false;
    const float* base; float* out; const float* gate;
    __device__ __forceinline__ void operator()(const f32x4 (&acc)[2][2][4][2], const Unit& u, int wr, int wc, int fr, int fq) const {
        const int row0 = u.pm * BM + wr * 64 + fr, col0 = u.pn * BM + wc * 32 + 4 * fq;
        const float* gp = gate + (size_t)((u.pm * BM) / SEQ) * MODW + col0;
        f32x4 gv[2][2];
#pragma unroll
        for (int bj = 0; bj < 2; ++bj)
#pragma unroll
            for (int n = 0; n < 2; ++n) gv[bj][n] = *(const f32x4*)(gp + bj * HALF + n * 16);
#pragma unroll
        for (int ai = 0; ai < 2; ++ai)
#pragma unroll
            for (int m = 0; m < 4; ++m) { const size_t off = (size_t)(row0 + ai * HALF + m * 16) * D + col0;
#pragma unroll
                for (int bj = 0; bj < 2; ++bj)
#pragma unroll
                    for (int n = 0; n < 2; ++n) { const f32x4 bs = *(const f32x4*)(base + off + bj * HALF + n * 16); *(f32x4*)(out + off + bj * HALF + n * 16) = bs + gv[bj][n] * acc[ai][bj][m][n]; } }
    }
};
}

constexpr int ATT_KB_OFF = 86016;
__device__ __forceinline__ void fox_attention(Frame& F, char* ldsg) {
    LAS float* kb = (LAS float*)(F.lds + ATT_KB_OFF);
    LAS float* wsum = (LAS float*)(F.lds + ATT_KB_OFF + 8192);
    const attn_body::bf16* Q = (const attn_body::bf16*)F.BIG; const attn_body::bf16* K = Q + (size_t)M * D; const attn_body::bf16* V = K + (size_t)M * D;
    for (int bh = F.vcu; bh < BATCH * NH; bh += F.G) {
        { const f32x4 v = *(const f32x4*)(F.LOGF + (size_t)bh * SEQ + 4 * F.tid);
          const float c0 = v.x, c1 = c0 + v.y, c2 = c1 + v.z, c3 = c2 + v.w;
          float inc = c3;
#pragma unroll
          for (int o = 1; o < 64; o <<= 1) { const float t = __shfl_up(inc, o); if (F.lane >= o) inc += t; }
          if (F.lane == 63) wsum[F.wave] = inc;
          __syncthreads();
          float off = 0.f;
#pragma unroll
          for (int w = 0; w < 8; ++w) { const float t = wsum[w]; if (w < F.wave) off += t; }
          const float ex = inc - c3 + off;
          *(LAS f32x4*)(kb + 4 * F.tid) = (f32x4){-(ex + c0) * LOG2E, -(ex + c1) * LOG2E, -(ex + c2) * LOG2E, -(ex + c3) * LOG2E};
          __syncthreads(); }
        const int b = bh / NH, h = bh % NH;
#pragma unroll 1
        for (int qb = SEQ / 256 - 1; qb >= 0; --qb) attn_body::attn_unit<8>(b, h, qb, Q, K, V, (attn_body::bf16*)F.BIG, ldsg, kb);
        __syncthreads();
    }
}

__device__ __forceinline__ float log_sigmoid_fast(float z) { return fminf(z, 0.f) - __logf(1.f + __expf(-fabsf(z))); }
__device__ __forceinline__ void gla_prep(Frame& F) {
    LAS float* s_alr = (LAS float*)F.lds;
    LAS float* s_seg = (LAS float*)(F.lds + 4096);
    LAS unsigned short* s_q = (LAS unsigned short*)(F.lds + 8192);
    LAS unsigned short* s_k = (LAS unsigned short*)(F.lds + 25600);
    LAS unsigned short* s_v = (LAS unsigned short*)(F.lds + 43008);
    const int tid = F.tid, kd = tid & 127, tq = tid >> 7;
    constexpr int NIT = BATCH * NCH * 4;
    f32x4 pa = (f32x4){0.f, 0.f, 0.f, 0.f}; v4u pq[2], pk[2], pv[4];
#define GP_LOAD(it_) do { const int h_ = (it_) & 3; const size_t m0_ = (size_t)((it_) >> 2) * 64; \
        if (tid < 256) pa = *(const f32x4*)(F.ALR + m0_ * 16 + tid * 4); \
        _Pragma("unroll") for (int i_ = 0; i_ < 2; ++i_) { const int p_ = tid + 512 * i_; const bf16* src_ = F.BIG + (m0_ + (p_ >> 4)) * 3072 + h_ * 128 + (p_ & 15) * 8; pq[i_] = *(const GAS v4u*)src_; pk[i_] = *(const GAS v4u*)(src_ + 512); } \
        _Pragma("unroll") for (int i_ = 0; i_ < 4; ++i_) { const int p_ = tid + 512 * i_; pv[i_] = *(const GAS v4u*)(F.BIG + (m0_ + (p_ >> 5)) * 3072 + 1024 + h_ * 256 + (p_ & 31) * 8); } } while (0)
    if (F.vcu < NIT) GP_LOAD(F.vcu);
    int hcur = -1; float w[16], ba = 0.f;
#pragma unroll 1
    for (int it = F.vcu; it < NIT; it += F.G) {
        const int h = it & 3;
        if (tid < 256) ((LAS f32x4*)s_alr)[tid] = pa;
#pragma unroll
        for (int i = 0; i < 2; ++i) { const int p = tid + 512 * i; *(LAS v4u*)(s_q + (p >> 4) * 136 + (p & 15) * 8) = pq[i]; *(LAS v4u*)(s_k + (p >> 4) * 136 + (p & 15) * 8) = pk[i]; }
#pragma unroll
        for (int i = 0; i < 4; ++i) { const int p = tid + 512 * i; *(LAS v4u*)(s_v + (p >> 5) * 264 + (p & 31) * 8) = pv[i]; }
        if (it + F.G < NIT) GP_LOAD(it + F.G);
        if (h != hcur) { hcur = h;
#pragma unroll
            for (int r = 0; r < 16; ++r) w[r] = F.gla_w_a2[r * 512 + h * 128 + kd];
            ba = F.gla_b_a[h * 128 + kd]; }
        __syncthreads();
        float cs[16]; float run = 0.f;
#pragma unroll
        for (int tt = 0; tt < 16; ++tt) { const LAS f32x4* ap = (const LAS f32x4*)(s_alr + (16 * tq + tt) * 16); float z = ba;
#pragma unroll
            for (int q = 0; q < 4; ++q) { const f32x4 a = ap[q]; z += a.x * w[4 * q] + a.y * w[4 * q + 1] + a.z * w[4 * q + 2] + a.w * w[4 * q + 3]; }
            run += log_sigmoid_fast(z) * (1.f / 16.f); cs[tt] = run; }
        s_seg[tq * 128 + kd] = run;
        __syncthreads();
        float off = 0.f, tot = 0.f;
#pragma unroll
        for (int q = 0; q < 4; ++q) { const float sv = s_seg[q * 128 + kd]; tot += sv; if (q < tq) off += sv; }
        const float etot = __expf(tot);
        unsigned kdp[8];
#pragma unroll
        for (int tt = 0; tt < 16; ++tt) { const int t = 16 * tq + tt; const float bb = cs[tt] + off; const float q = bf2f(s_q[t * 136 + kd]), k = bf2f(s_k[t * 136 + kd]);
            const float eb = __expf(bb), ei = __builtin_amdgcn_rcpf(eb);
            s_q[t * 136 + kd] = (unsigned short)f2bf(q * 0.08838834764831845f * eb); s_k[t * 136 + kd] = (unsigned short)f2bf(k * ei);
            const unsigned kv = f2bf(k * etot * ei);
            if (tt & 1) kdp[tt >> 1] |= kv << 16; else kdp[tt >> 1] = kv; }
        { GAS v4u* dp = (GAS v4u*)(F.GKDT + (size_t)it * 8192 + kd * 64 + 16 * tq); dp[0] = (v4u){kdp[0], kdp[1], kdp[2], kdp[3]}; dp[1] = (v4u){kdp[4], kdp[5], kdp[6], kdp[7]}; }
        if (tq == 0) F.DEC[(size_t)it * 128 + kd] = etot;
        { const int vc = tid & 255, hf = tid >> 8; unsigned pkv[16];
#pragma unroll
          for (int q = 0; q < 16; ++q) { const int t = 32 * hf + 2 * q; pkv[q] = (unsigned)s_v[t * 264 + vc] | ((unsigned)s_v[(t + 1) * 264 + vc] << 16); }
          GAS v4u* dp = (GAS v4u*)(F.GVT + (size_t)it * 16384 + vc * 64 + 32 * hf);
#pragma unroll
          for (int q = 0; q < 4; ++q) dp[q] = (v4u){pkv[4 * q], pkv[4 * q + 1], pkv[4 * q + 2], pkv[4 * q + 3]}; }
        __syncthreads();
#pragma unroll
        for (int i = 0; i < 2; ++i) { const int p = tid + 512 * i;
            ((GAS v4u*)(F.GQI + (size_t)it * 8192))[p] = *(const LAS v4u*)(s_q + (p >> 4) * 136 + (p & 15) * 8);
            ((GAS v4u*)(F.GKI + (size_t)it * 8192))[p] = *(const LAS v4u*)(s_k + (p >> 4) * 136 + (p & 15) * 8); }
    }
#undef GP_LOAD
    __syncthreads();
}

__device__ __forceinline__ void gla_scan(Frame& F) {
    constexpr int P128 = 272, P64 = 144;
    constexpr int O_QI = 0, O_KI = O_QI + 64 * P128, O_KDT = O_KI + 64 * P128, O_VT = O_KDT + 128 * P64, O_A = O_VT + 64 * P64, O_ST0 = O_A + 64 * P64, O_ST1 = O_ST0 + 64 * P128, O_DEC = O_ST1 + 64 * P128;
    static_assert(O_DEC + 512 <= RING_BYTES, "gla_scan LDS");
    LAS unsigned char* lds = F.lds;
    const int tid = F.tid, lane = F.lane, w = F.wave, fr = lane & 15, fq = lane >> 4;
    typedef unsigned u32x2 __attribute__((ext_vector_type(2)));
#define MFMA16(a, b, c) __builtin_amdgcn_mfma_f32_16x16x32_bf16((a), (b), (c), 0, 0, 0)
    for (int u = F.vcu; u < 256; u += F.G) {
        const int bh = u >> 2, vs = u & 3, b = bh >> 2, h = bh & 3;
        for (int p = tid; p < (64 * P128) / 16; p += NTHR) *(LAS v4u*)(lds + O_ST0 + p * 16) = (v4u){0u, 0u, 0u, 0u};
        f32x4 S[4];
#pragma unroll
        for (int j = 0; j < 4; ++j) S[j] = (f32x4){0.f, 0.f, 0.f, 0.f};
        v4u rq[2], rk[2], rd[2], rv; float rdec = 0.f;
#define GS_LOAD(n) do { const size_t it_ = (size_t)((b * NCH + (n)) * 4 + h); \
        const GAS v4u* q_ = (const GAS v4u*)(F.GQI + it_ * 8192); const GAS v4u* k_ = (const GAS v4u*)(F.GKI + it_ * 8192); const GAS v4u* d_ = (const GAS v4u*)(F.GKDT + it_ * 8192); \
        rq[0] = q_[tid]; rq[1] = q_[tid + 512]; rk[0] = k_[tid]; rk[1] = k_[tid + 512]; rd[0] = d_[tid]; rd[1] = d_[tid + 512]; \
        rv = ((const GAS v4u*)(F.GVT + it_ * 16384 + vs * 4096))[tid]; if (tid < 128) rdec = F.DEC[it_ * 128 + tid]; } while (0)
        GS_LOAD(0);
#pragma unroll 1
        for (int n = 0; n < NCH; ++n) {
            __syncthreads();
#pragma unroll
            for (int i = 0; i < 2; ++i) { const int p = tid + 512 * i;
                *(LAS v4u*)(lds + O_QI + (p >> 4) * P128 + (p & 15) * 16) = rq[i]; *(LAS v4u*)(lds + O_KI + (p >> 4) * P128 + (p & 15) * 16) = rk[i];
                *(LAS v4u*)(lds + O_KDT + (p >> 3) * P64 + (p & 7) * 16) = rd[i]; }
            *(LAS v4u*)(lds + O_VT + (tid >> 3) * P64 + (tid & 7) * 16) = rv;
            if (tid < 128) ((LAS float*)(lds + O_DEC))[tid] = rdec;
            if (n + 1 < NCH) GS_LOAD(n + 1);
            __syncthreads();
            const int tb = w & 3, g2 = 2 * (w >> 2);
            bf16x8 qf[4];
#pragma unroll
            for (int kk = 0; kk < 4; ++kk) qf[kk] = *(const LAS bf16x8*)(lds + O_QI + (16 * tb + fr) * P128 + fq * 16 + kk * 64);
#pragma unroll
            for (int j = 0; j < 2; ++j) { const int sb = g2 + j; f32x4 a = (f32x4){0.f, 0.f, 0.f, 0.f};
#pragma unroll
                for (int kk = 0; kk < 4; ++kk) { const bf16x8 kf = *(const LAS bf16x8*)(lds + O_KI + (16 * sb + fr) * P128 + fq * 16 + kk * 64); a = MFMA16(kf, qf[kk], a); }
                const int t = 16 * tb + fr, s0 = 16 * sb + 4 * fq;
                u32x2 pkd; pkd.x = pk2(s0 + 0 <= t ? a[0] : 0.f, s0 + 1 <= t ? a[1] : 0.f); pkd.y = pk2(s0 + 2 <= t ? a[2] : 0.f, s0 + 3 <= t ? a[3] : 0.f);
                *(LAS u32x2*)(lds + O_A + t * P64 + s0 * 2) = pkd; }
            { const f32x4 dv = *(const LAS f32x4*)(lds + O_DEC + (16 * w + 4 * fq) * 4);
              bf16x8 af[2];
#pragma unroll
              for (int kk = 0; kk < 2; ++kk) af[kk] = *(const LAS bf16x8*)(lds + O_KDT + (16 * w + fr) * P64 + fq * 16 + kk * 64);
              const int stn = ((n + 1) & 1) ? O_ST1 : O_ST0;
#pragma unroll
              for (int j = 0; j < 4; ++j) { S[j] = S[j] * dv;
#pragma unroll
                  for (int kk = 0; kk < 2; ++kk) { const bf16x8 vf = *(const LAS bf16x8*)(lds + O_VT + (16 * j + fr) * P64 + fq * 16 + kk * 64); S[j] = MFMA16(af[kk], vf, S[j]); }
                  u32x2 pkd; pkd.x = pk2(S[j][0], S[j][1]); pkd.y = pk2(S[j][2], S[j][3]);
                  *(LAS u32x2*)(lds + stn + (16 * j + fr) * P128 + (16 * w + 4 * fq) * 2) = pkd; } }
            __syncthreads();
            { const int stc = (n & 1) ? O_ST1 : O_ST0;
              bf16x8 a2[2];
#pragma unroll
              for (int kk = 0; kk < 2; ++kk) a2[kk] = *(const LAS bf16x8*)(lds + O_A + (16 * tb + fr) * P64 + fq * 16 + kk * 64);
              const size_t mrow = (size_t)b * SEQ + n * 64 + 16 * tb + fr;
#pragma unroll
              for (int j = 0; j < 2; ++j) { const int vcb = g2 + j; f32x4 o = (f32x4){0.f, 0.f, 0.f, 0.f};
#pragma unroll
                  for (int kk = 0; kk < 2; ++kk) { const bf16x8 vf = *(const LAS bf16x8*)(lds + O_VT + (16 * vcb + fr) * P64 + fq * 16 + kk * 64); o = MFMA16(vf, a2[kk], o); }
#pragma unroll
                  for (int kk = 0; kk < 4; ++kk) { const bf16x8 sf = *(const LAS bf16x8*)(lds + stc + (16 * vcb + fr) * P128 + fq * 16 + kk * 64); o = MFMA16(sf, qf[kk], o); }
                  u32x2 pkd; pkd.x = pk2(o[0], o[1]); pkd.y = pk2(o[2], o[3]);
                  *(GAS u32x2*)(F.BIG + mrow * 3072 + h * 256 + vs * 64 + 16 * vcb + 4 * fq) = pkd; } }
        }
        __syncthreads();
    }
#undef GS_LOAD
#undef MFMA16
}

__global__ void __launch_bounds__(NTHR, 2) fwd_megakernel(Args args) {
    extern __shared__ __attribute__((aligned(16))) unsigned char lds[];
    Frame F;
    F.lds = (LAS unsigned char*)lds;
    F.tid = threadIdx.x; F.lane = F.tid & 63; F.wave = __builtin_amdgcn_readfirstlane(F.tid >> 6);
    F.G = gridDim.x; { const int bx = blockIdx.x; F.vcu = (F.G % 8 == 0) ? (bx % 8) * (F.G / 8) + bx / 8 : bx; }
    F.x = args.in[0]; F.c = args.in[1]; F.ada_w = args.in[2]; F.ada_b = args.in[3]; F.norm1_g = args.in[4]; F.norm2_g = args.in[5]; F.ffn_w_in = args.in[6]; F.ffn_w_out = args.in[7];
    F.fox_w_in = args.in[8]; F.fox_b_f = args.in[9]; F.fox_w_out = args.in[10]; F.gla_w_in = args.in[11]; F.gla_w_a2 = args.in[12]; F.gla_b_a = args.in[13]; F.gla_g_o = args.in[14]; F.gla_w_out = args.in[15]; F.final_g = args.in[16];
    F.out = args.out; F.ws = args.ws;
    unsigned char* ws = args.ws;
    F.MOD = (float*)(ws + WS_MOD); F.LOGF = (float*)(ws + WS_LOGF); F.ALR = (float*)(ws + WS_ALR); F.DEC = (float*)(ws + WS_DEC);
    F.XN = (bf16*)(ws + WS_XN); F.BIG = (bf16*)(ws + WS_BIG); F.GQI = (bf16*)(ws + WS_GQI); F.GKI = (bf16*)(ws + WS_GKI); F.GKDT = (bf16*)(ws + WS_GKDT); F.GVT = (bf16*)(ws + WS_GVT);
    const int lo = args.ph_lo, hi = args.ph_hi;
    bool first = true;
    if (F.tid < 64) ((LAS unsigned*)(F.lds + RING_BYTES))[F.tid + 64] = 0u;
    __syncthreads();
#if MK_MULTI
#define GRID_BAR() ((void)0)
#else
    XcdBarrier bar = xcd_barrier_post((unsigned*)(ws + WS_CTL) + CW_BAR, (volatile LAS unsigned*)(F.lds + MISC_OFF) + 8);
    bool cgdone = false;
#define GRID_BAR() (cgdone ? xcd_barrier(bar) : (cg::this_grid().sync(), (void)(cgdone = true)))
#endif
#define PHASE(id) if (lo <= (id) && (id) < hi && ((first ? (void)0 : (void)(GRID_BAR())), first = false, frame_tid(F), true))

    PHASE(0) { for (int rep_ = 0; rep_ < REP_P0; ++rep_) { p0_prologue(F); __syncthreads(); } }
#pragma unroll 1
    for (int l = 0; l < 2; ++l) {
        const int pb = 1 + 9 * l;
        const float* modl = F.MOD + (size_t)l * 16 * MODW;
        const float* xcur = l == 0 ? F.x : F.out;
        PHASE(pb + 0) { norm_pass(F, xcur, F.norm1_g + l * D, modl, 0, l, l == 0 ? F.fox_w_in : F.gla_w_in); }
        PHASE(pb + 1) {
            pg8::Gemm g{F.XN, (const bf16*)(ws + (l ? WS_WIN1 : WS_WIN0)), M, 3 * D, D}; pg8::StaticOrder S; S.init(M, 3 * D, F.G, (int)blockIdx.x);
            pg8::EpiBf16<0> E{F.BIG, l == 0 ? D : 3 * D, nullptr, l == 0 ? D : 0, (size_t)M * D, attn_body::C2};
            pg8::gemm_phase<pg8::EpiBf16<0>, pg8::StaticOrder, PG8_ALIGN, PG8_SP2>(F.lds, g, S, E);
        }
        if (l == 0) {
            PHASE(pb + 2) { fox_attention(F, (char*)lds); }
        } else {
            PHASE(pb + 2) { for (int rep_ = 0; rep_ < REP_PREP; ++rep_) gla_prep(F); }
            PHASE(pb + 3) { for (int rep_ = 0; rep_ < REP_SCAN; ++rep_) gla_scan(F); }
            PHASE(pb + 4) { gla_onorm(F); }
        }
        PHASE(pb + 5) {
            pg8::Gemm g{l == 0 ? F.BIG : F.XN, (const bf16*)(ws + (l ? WS_WOUT1 : WS_WOUT0)), M, D, D}; pg8::StaticOrder S; S.init(M, D, F.G, (int)blockIdx.x);
            pg8::EpiResGate E{xcur, F.out, modl + 2 * D};
            pg8::gemm_phase<pg8::EpiResGate, pg8::StaticOrder, PG8_ALIGN, PG8_SP2>(F.lds, g, S, E);
        }
        PHASE(pb + 6) { for (int rep_ = 0; rep_ < REP_NORM; ++rep_) norm_pass(F, F.out, F.norm2_g + l * D, modl, 3, 2, nullptr); }
        PHASE(pb + 7) {
            pg8::Gemm g{F.XN, (const bf16*)(ws + (l ? WS_FIN1 : WS_FIN0)), M, 2 * FFH, D}; pg8::StaticOrder S; S.init(M, 2 * FFH, F.G, (int)blockIdx.x);
            pg8::EpiSwiGLU E{F.BIG, FFH};
            pg8::gemm_phase<pg8::EpiSwiGLU, pg8::StaticOrder, PG8_ALIGN, PG8_SP2>(F.lds, g, S, E);
        }
        PHASE(pb + 8) {
            pg8::Gemm g{F.BIG, (const bf16*)(ws + (l ? WS_FOUT1 : WS_FOUT0)), M, D, FFH}; pg8::StaticOrder S; S.init(M, D, F.G, (int)blockIdx.x);
            pg8::EpiResGate E{F.out, F.out, modl + 5 * D};
            pg8::gemm_phase<pg8::EpiResGate, pg8::StaticOrder, PG8_ALIGN, PG8_SP2>(F.lds, g, S, E);
        }
    }
    PHASE(19) { final_norm(F); }
#undef PHASE
}

constexpr int N_PHASES = 20;
extern "C" void kernel_launch(void* const* d_in, const int* in_sizes, int n_in, void* d_out, int out_size, void* d_ws, size_t ws_size, hipStream_t stream) {
    static int grid = 0;
    if (grid == 0) {
        if (n_in != 17 || in_sizes[0] != M * D || out_size != M * D || ws_size < WS_END) { fprintf(stderr, "kernel_launch: unexpected problem: n_in %d in0 %d out %d ws %zu (need %zu)\n", n_in, n_in > 0 ? in_sizes[0] : -1, out_size, ws_size, (size_t)WS_END); grid = -1; return; }
        int dev = 0, cus = 0, per_cu = 0;
        if (hipGetDevice(&dev) != hipSuccess || hipDeviceGetAttribute(&cus, hipDeviceAttributeMultiprocessorCount, dev) != hipSuccess) { grid = -1; return; }
        if (hipFuncSetAttribute((const void*)fwd_megakernel, hipFuncAttributeMaxDynamicSharedMemorySize, LDS_BYTES) != hipSuccess) { fprintf(stderr, "kernel_launch: hipFuncSetAttribute failed\n"); grid = -1; return; }
        if (hipOccupancyMaxActiveBlocksPerMultiprocessor(&per_cu, (const void*)fwd_megakernel, NTHR, LDS_BYTES) != hipSuccess || per_cu < 1) { fprintf(stderr, "kernel_launch: occupancy query says %d blocks/CU\n", per_cu); per_cu = 1; }
        (void)hipGetLastError();
        grid = cus * 1;
    }
    if (grid < 0) return;
    if (hipMemsetAsync((char*)d_ws + WS_CTL, 0, 65536, stream) != hipSuccess) { fprintf(stderr, "kernel_launch: memset of the barrier words failed\n"); return; }
    Args a{};
    for (int i = 0; i < 17; ++i) a.in[i] = (const float*)d_in[i];
    a.out = (float*)d_out; a.ws = (unsigned char*)d_ws;
#if MK_MULTI
    for (int p = 0; p < N_PHASES; ++p) { if (p == 4 || p == 5) continue; a.ph_lo = p; a.ph_hi = p + 1; hipLaunchKernelGGL(fwd_megakernel, dim3(grid), dim3(NTHR), LDS_BYTES, stream, a); }
#else
    a.ph_lo = 0; a.ph_hi = N_PHASES;
    void* kargs[] = {&a};
    const hipError_t e = hipLaunchCooperativeKernel((const void*)fwd_megakernel, dim3(grid), dim3(NTHR), kargs, LDS_BYTES, stream);
    if (e != hipSuccess) fprintf(stderr, "kernel_launch: cooperative launch failed: %s (grid %d)\n", hipGetErrorString(e), grid);
#endif
}
```
